# Optimizing an MI355X kernel written in HIP

```python
import jax, jax.numpy as jnp
from jax import lax
import numpy as np

D_MODEL = 4096
BATCH = 4
SEQ = 2048
DEPTH = 4
DEC_BATCH = 128
DEC_SEQ = 8
PAST_LEN = 16384
PAGE_SIZE = 128

POOL_WINDOWS = (2, 4, 8, 16)
POOL_GROUPS = len(POOL_WINDOWS)
POOL_WIDTH = D_MODEL // 2
POOL_GROUP_DIM = POOL_WIDTH // POOL_GROUPS
POOL_BUF = max(POOL_WINDOWS) - 1
SGU_HEADS = 8
SGU_WIDTH = D_MODEL // 2
SGU_HEAD_DIM = SGU_WIDTH // SGU_HEADS
CHUNK = 128
EPS = 1e-6
COL_SIZES = (POOL_WIDTH, POOL_WIDTH, SGU_WIDTH, SGU_WIDTH, SGU_WIDTH, D_MODEL, D_MODEL)
COL_SPLITS = tuple(int(s) for s in np.cumsum(COL_SIZES)[:-1])
IN_COLS = int(sum(COL_SIZES))

kernel_name = "hybrid_pool_sgu_decoder_step"


def rmsnorm(x, g):
    xf = x.astype(jnp.float32)
    r = xf * lax.rsqrt(jnp.mean(xf * xf, axis=-1, keepdims=True) + EPS)
    return (r * g.astype(jnp.float32)).astype(x.dtype)


def pool_mixer(a, buf, pos0, w_group, scale):
    B, T, P = a.shape
    full = jnp.concatenate([buf.astype(a.dtype), a], axis=1)
    c = jnp.cumsum(full.astype(jnp.float32), axis=1)
    c0 = jnp.concatenate([jnp.zeros((B, 1, P), jnp.float32), c], axis=1)
    pos = pos0 + jnp.arange(T, dtype=jnp.int32)
    outs = []
    for gi, w in enumerate(POOL_WINDOWS):
        sl = slice(gi * POOL_GROUP_DIM, (gi + 1) * POOL_GROUP_DIM)
        hi = c0[:, POOL_BUF + 1:POOL_BUF + 1 + T, sl]
        lo = c0[:, POOL_BUF + 1 - w:POOL_BUF + 1 - w + T, sl]
        cnt = jnp.minimum(pos + 1, w).astype(jnp.float32)[None, :, None]
        outs.append((hi - lo) / cnt)
    pooled = jnp.concatenate(outs, axis=-1) - a.astype(jnp.float32)
    pooled = pooled.reshape(B, T, POOL_GROUPS, POOL_GROUP_DIM).astype(a.dtype)
    mixed = jnp.einsum('btgc,gcd->btgd', pooled, w_group).reshape(B, T, P)
    new_buf = full[:, -POOL_BUF:]
    return mixed * scale, new_buf


def sgu_mixer(u, v, pos0, norm_g, w_s, b_s):
    assert pos0 % CHUNK == 0
    B, T, W = v.shape
    v_n = rmsnorm(v, norm_g)
    n_chunks = -(-T // CHUNK)
    Tp = n_chunks * CHUNK
    vp = jnp.pad(v_n, ((0, 0), (0, Tp - T), (0, 0)))
    vc = vp.reshape(B, n_chunks, CHUNK, SGU_HEADS, SGU_HEAD_DIM)
    mask = jnp.tril(jnp.ones((CHUNK, CHUNK), dtype=bool))
    ws = jnp.where(mask[None], w_s, jnp.zeros((), w_s.dtype))
    z = jnp.einsum('hts,bnshd->bnthd', ws, vc) + b_s.T[None, None, :, :, None]
    z = z.reshape(B, Tp, W)[:, :T]
    return u * z, v_n


def layer(x, pos0, pool_buf, norm_g, w_in, pool_w, pool_scale, sgu_norm_g, sgu_w, sgu_b,
          w_branch_a, w_branch_b, w_out):
    h = rmsnorm(x, norm_g)
    proj = jnp.einsum('btd,dc->btc', h, w_in)
    a, gate_a, u, v, gate_b, sel_a, sel_b = jnp.split(proj, COL_SPLITS, axis=-1)
    ya, new_buf = pool_mixer(a, pool_buf, pos0, pool_w, pool_scale)
    ya = ya * jax.nn.silu(gate_a)
    yb, v_n = sgu_mixer(u, v, pos0, sgu_norm_g, sgu_w, sgu_b)
    yb = yb * jax.nn.silu(gate_b)
    merged = (jax.nn.sigmoid(sel_a) * jnp.einsum('btp,pd->btd', ya, w_branch_a)
              + jax.nn.sigmoid(sel_b) * jnp.einsum('btw,wd->btd', yb, w_branch_b))
    return x + jnp.einsum('btd,de->bte', merged, w_out), new_buf, v_n


def setup_inputs(seed: int = 0) -> dict:
    key = jax.random.key(seed)
    ks = jax.random.split(key, 16)
    f32 = jnp.float32
    nrm = lambda k, shape, s: jax.random.normal(k, shape, f32) * s
    return {
        "x_prompt": nrm(ks[0], (BATCH, SEQ, D_MODEL), 1.0),
        "x_sample": nrm(ks[1], (DEC_BATCH, DEC_SEQ, D_MODEL), 1.0),
        "state_pool": nrm(ks[2], (DEPTH, DEC_BATCH, POOL_BUF, POOL_WIDTH), 1.0),
        "norm_g": 1.0 + nrm(ks[3], (DEPTH, D_MODEL), 0.02),
        "w_in": nrm(ks[4], (DEPTH, D_MODEL, IN_COLS), D_MODEL ** -0.5),
        "pool_w": nrm(ks[5], (DEPTH, POOL_GROUPS, POOL_GROUP_DIM, POOL_GROUP_DIM), POOL_GROUP_DIM ** -0.5),
        "pool_scale": 1.0 + nrm(ks[6], (DEPTH, POOL_WIDTH), 0.1),
        "sgu_norm_g": 1.0 + nrm(ks[7], (DEPTH, SGU_WIDTH), 0.02),
        "sgu_w": nrm(ks[8], (DEPTH, SGU_HEADS, CHUNK, CHUNK), 0.5 * CHUNK ** -0.5),
        "sgu_b": 1.0 + nrm(ks[9], (DEPTH, SGU_HEADS, CHUNK), 0.02),
        "w_branch_a": nrm(ks[10], (DEPTH, POOL_WIDTH, D_MODEL), POOL_WIDTH ** -0.5),
        "w_branch_b": nrm(ks[11], (DEPTH, SGU_WIDTH, D_MODEL), SGU_WIDTH ** -0.5),
        "w_out": nrm(ks[12], (DEPTH, D_MODEL, D_MODEL), D_MODEL ** -0.5),
        "final_norm_g": 1.0 + nrm(ks[13], (D_MODEL,), 0.02),
    }


def reference(x_prompt, x_sample, state_pool, norm_g, w_in, pool_w, pool_scale, sgu_norm_g,
              sgu_w, sgu_b, w_branch_a, w_branch_b, w_out, final_norm_g):
    xp = x_prompt
    xs = x_sample
    zero_buf = jnp.zeros((xp.shape[0], POOL_BUF, POOL_WIDTH), xp.dtype)
    pool_p, pool_s, sgu_v_s = [], [], []
    for l in range(DEPTH):
        params = (norm_g[l], w_in[l], pool_w[l], pool_scale[l], sgu_norm_g[l], sgu_w[l], sgu_b[l],
                  w_branch_a[l], w_branch_b[l], w_out[l])
        xp, nb_p, _ = layer(xp, 0, zero_buf, *params)
        xs, nb_s, vn_s = layer(xs, PAST_LEN, state_pool[l], *params)
        pool_p.append(nb_p)
        pool_s.append(nb_s)
        sgu_v_s.append(vn_s)
    y_prompt = rmsnorm(xp, final_norm_g)
    y_sample = rmsnorm(xs, final_norm_g)
    state_pool_prompt = jnp.stack(pool_p, axis=0)
    state_pool_sample = jnp.stack(pool_s, axis=0)
    state_sgu_v_sample = jnp.stack(sgu_v_s, axis=0)
    return (y_prompt, y_sample, state_pool_prompt, state_pool_sample, state_sgu_v_sample)
```

```cpp
#include <hip/hip_runtime.h>
#include <cstdio>
#include <cstdint>

#ifndef DATAFLOW
#define DATAFLOW 0
#endif
#ifndef N_LAUNCHES
#define N_LAUNCHES 1
#endif

#define LAS __attribute__((address_space(3)))
#define GAS __attribute__((address_space(1)))
typedef unsigned short bf16;
typedef short bf16x8 __attribute__((ext_vector_type(8)));
typedef float f32x4 __attribute__((ext_vector_type(4)));
typedef unsigned u32x4 __attribute__((ext_vector_type(4)));
typedef unsigned u32x2 __attribute__((ext_vector_type(2)));

constexpr int DM = 4096, NBATCH = 4, SEQ = 2048, DEPTH = 4, DBATCH = 128, DSEQ = 8;
constexpr int MP = NBATCH * SEQ, MS = DBATCH * DSEQ, MR = MP + MS;
constexpr int PW = 2048, INC = 18432, NPAN = MR / 256, NPP = MP / 256;
constexpr float EPS = 1e-6f;
constexpr size_t O_Y = 0, O_SPP = (size_t)MR * DM, O_SPS = O_SPP + (size_t)DEPTH * NBATCH * 15 * PW, O_SGV = O_SPS + (size_t)DEPTH * DBATCH * 15 * PW,
                 O_END = O_SGV + (size_t)DEPTH * DBATCH * DSEQ * PW;

constexpr size_t MiB = 1u << 20;
constexpr size_t WS_CTL = 0, CTL_ZERO_BYTES = 1 * MiB;
constexpr size_t WS_WIN = 2 * MiB;
constexpr size_t WS_WBR = WS_WIN + (size_t)DEPTH * INC * DM * 2;
constexpr size_t WS_WO  = WS_WBR + (size_t)DEPTH * DM * DM * 2;
constexpr size_t WS_PWT = WS_WO + (size_t)DEPTH * DM * DM * 2;
constexpr size_t WS_WBLK = WS_PWT + (size_t)DEPTH * 4 * 512 * 512 * 2;
constexpr size_t WS_XF = WS_WBLK + (size_t)DEPTH * 8 * 2 * 65536 * 2;
constexpr size_t WS_XB = WS_XF + (size_t)MR * DM * 4;
constexpr size_t WS_A = WS_XB + (size_t)MR * DM * 2;
constexpr size_t WS_V = WS_A + (size_t)MR * PW * 2;
constexpr size_t WS_SGA = WS_V + (size_t)MR * PW * 2;
constexpr size_t WS_UG = WS_SGA + (size_t)MR * PW * 2;
constexpr size_t WS_RATIO = WS_UG + (size_t)MR * PW * 2;
constexpr size_t WS_SIGB = WS_RATIO + (size_t)MR * DM * 2;
constexpr size_t WS_POOLED = WS_SIGB + (size_t)MR * DM * 2;
constexpr size_t WS_VNT = WS_POOLED + (size_t)MR * PW * 2;
constexpr size_t WS_YCAT = WS_VNT + (size_t)MR * PW * 2;
constexpr size_t WS_MERGED = WS_YCAT + (size_t)MR * DM * 2;
constexpr size_t WS_HALO = WS_MERGED + (size_t)MR * DM * 2;
constexpr size_t WS_TMP = WS_HALO + (size_t)DEPTH * NPAN * 15 * PW * 2;
constexpr size_t WS_END = WS_TMP + (size_t)MR * DM * 4;
constexpr int CW_TMO = 0, CW_BAR = 4096, CW_SUMSQ = 16384  , CW_E1 = 65536  , CW_CNT = 81920  ;
static_assert((CW_CNT + DEPTH * NPAN * 8 * 16) * 4 <= (int)CTL_ZERO_BYTES, "ctl");
static_assert(CW_SUMSQ + 5 * MR <= CW_E1 && CW_E1 + DEPTH * NPAN * 72 <= CW_CNT, "ctl map");

constexpr int RING_BYTES = 131072, MISC_OFF = RING_BYTES + 64, LDS_BYTES = 147456;
constexpr int HTB = 128 * 64 * 2;

#define LDS_WAIT() asm volatile("s_waitcnt lgkmcnt(0)" ::: "memory")
#define VM_WAIT() asm volatile("s_waitcnt vmcnt(0)" ::: "memory")
typedef float f32x2_t __attribute__((ext_vector_type(2)));
typedef __bf16 bf16x2_t __attribute__((ext_vector_type(2)));
__device__ __forceinline__ unsigned cvt_pk_bf16(float lo, float hi) { const f32x2_t v = {lo, hi}; return __builtin_bit_cast(unsigned, __builtin_convertvector(v, bf16x2_t)); }
__device__ __forceinline__ float bf_lo(unsigned w) { return __uint_as_float(w << 16); }
__device__ __forceinline__ float bf_hi(unsigned w) { return __uint_as_float(w & 0xffff0000u); }
__device__ __forceinline__ float fast_exp(float x) { return __builtin_amdgcn_exp2f(x * 1.44269504f); }
__device__ __forceinline__ float fast_rcp(float x) { return __builtin_amdgcn_rcpf(x); }
__device__ __forceinline__ float silu_f(float x) { return x * fast_rcp(1.0f + fast_exp(-x)); }
__device__ __forceinline__ float wave_sum(float v) {
#pragma unroll
    for (int o = 1; o < 64; o <<= 1) v += __shfl_xor(v, o);
    return v;
}
__host__ __device__ __forceinline__ int lds_byte(int r, int c) { const int st = (r >> 4) * 2 + (c >> 5), rr = r & 15, cc = c & 31, ob = rr * 64 + cc * 2; return st * 1024 + (ob ^ (((ob >> 9) & 1) << 5)); }
__host__ __device__ __forceinline__ int invperm32(int i) { return 16 * ((i >> 2) & 1) + 4 * (i >> 3) + (i & 3); }

#define XB_TMO      128
#define XB_XCNT(j)  (256  + 64 * (j))
#define XB_XSUB(j)  (1280 + 64 * (j))
#define XB_XGEN(j)  (2304 + 64 * (j))
#define XB_TOP      3328
#define XB_TOPGEN   3392
#define XCD_BAR_WORDS 3456
#define XB_SPIN_CAP (1u << 18)
__device__ __forceinline__ unsigned xb_ld(unsigned* p)              { return __hip_atomic_load(p, __ATOMIC_RELAXED, __HIP_MEMORY_SCOPE_AGENT); }
__device__ __forceinline__ unsigned xb_add(unsigned* p, unsigned v) { return __hip_atomic_fetch_add(p, v, __ATOMIC_RELAXED, __HIP_MEMORY_SCOPE_AGENT); }
__device__ __forceinline__ unsigned xb_xcc_id() { return (unsigned)__builtin_amdgcn_s_getreg((3 << 11) | 20) & 0xFu; }
#define XB_SPIN(cond, bar) do { unsigned _sp = 0; while (cond) { __builtin_amdgcn_s_sleep(1); \
    if ((++_sp & 255u) == 0u) { if (xb_ld(&(bar)[XB_TMO])) break; if (_sp > XB_SPIN_CAP) { atomicAdd(&(bar)[XB_TMO], 1u); break; } } } } while (0)
struct XcdBarrier { unsigned* bar; unsigned x; volatile LAS unsigned* st; };
__device__ __forceinline__ XcdBarrier xcd_barrier_post(unsigned* bar, volatile LAS unsigned* st) {
    XcdBarrier b; b.bar = bar; b.x = xb_xcc_id(); b.st = st;
    if (threadIdx.x == 0) (void)xb_add(&bar[XB_XCNT(b.x)], 1u);
    return b;
}
__device__ __forceinline__ void xcd_barrier_complete(unsigned* bar, unsigned x, unsigned& nloc, unsigned& nx) {
    const unsigned G = gridDim.x * gridDim.y * gridDim.z;
    unsigned sum, cnt, mine, sp = 0u;
    for (;;) {
        sum = 0u; cnt = 0u; mine = 0u;
#pragma unroll
        for (unsigned j = 0; j < 16; ++j) { const unsigned c = xb_ld(&bar[XB_XCNT(j)]); sum += c; cnt += (c > 0u) ? 1u : 0u; mine = (j == x) ? c : mine; }
        if (sum == G) break;
        __builtin_amdgcn_s_sleep(1);
        if ((++sp & 255u) == 0u) { if (xb_ld(&bar[XB_TMO])) break; if (sp > XB_SPIN_CAP) { atomicAdd(&bar[XB_TMO], 1u); break; } }
    }
    nloc = mine > 0u ? mine : 1u; nx = cnt > 0u ? cnt : 1u;
}
__device__ __forceinline__ void xcd_barrier(const XcdBarrier& b) {
    asm volatile("s_waitcnt vmcnt(0)" ::: "memory");
    __syncthreads();
    if (threadIdx.x == 0) {
        unsigned* bar = b.bar; unsigned bx = b.x;
        asm volatile("" : "+s"(bar), "+s"(bx));
        __builtin_amdgcn_s_waitcnt(0);
        unsigned nloc = b.st[0], nx = b.st[1];
        if (nloc == 0u) { xcd_barrier_complete(bar, bx, nloc, nx); b.st[0] = nloc; b.st[1] = nx; }
        const unsigned old = xb_add(&bar[XB_XSUB(bx)], 1u);
        const unsigned gen = old / nloc;
        if (old + 1u == (gen + 1u) * nloc) {
            __builtin_amdgcn_fence(__ATOMIC_RELEASE, "agent");
            asm volatile("s_waitcnt vmcnt(0)" ::: "memory");
            const unsigned og = xb_add(&bar[XB_TOP], 1u);
            const unsigned tg = og / nx;
            if (og + 1u == (tg + 1u) * nx) xb_add(&bar[XB_TOPGEN], 1u);
            else XB_SPIN(xb_ld(&bar[XB_TOPGEN]) == tg, bar);
            __builtin_amdgcn_fence(__ATOMIC_ACQUIRE, "agent");
            xb_add(&bar[XB_XGEN(bx)], 1u);
            asm volatile("s_waitcnt vmcnt(0)" ::: "memory");
        } else {
            XB_SPIN(xb_ld(&bar[XB_XGEN(bx)]) == gen, bar);
            __builtin_amdgcn_fence(__ATOMIC_ACQUIRE, "agent");
            asm volatile("s_waitcnt vmcnt(0)" ::: "memory");
        }
    }
    __syncthreads();
}

struct Params { const float* in[14]; float* out; unsigned char* ws; int ph_lo, ph_hi; };
enum { I_XP = 0, I_XS, I_STATE, I_NORMG, I_WIN, I_POOLW, I_PSCALE, I_SGUG, I_SGUW, I_SGUB, I_WBA, I_WBB, I_WOUT, I_FING };

struct Ctx {
    LAS unsigned char* lds;
    int tid, lane, wid;
    int G, W, xcd, rank;
};

constexpr int Q_P1 = 0, Q_PV = 324, Q_SM = 360, Q_BR = 432, Q_OUT = 504, Q_FIN = 576, Q_END = 612;
enum { K_P1 = 0, K_PV, K_PG, K_SG, K_BR, K_OUT, K_FIN };
struct Ent { int kind, p, j; };
__device__ __forceinline__ Ent decode_ent(int q, int x) {
    Ent e;
    if (q < Q_PV) { e.kind = K_P1; if (q < 288) { e.j = q >> 2; e.p = 4 * x + (q & 3); } else { const int i = q - 288; e.p = NPP + (x & 3); e.j = 2 * i + (x >> 2); } }
    else if (q < Q_SM || q >= Q_FIN) { const int t = (q >= Q_FIN) ? q - Q_FIN : q - Q_PV; e.kind = (q >= Q_FIN) ? K_FIN : K_PV;
        if (t < 32) { e.p = 4 * x + (t >> 3); e.j = t & 7; } else { const int id = 4 * x + (t - 32); e.p = NPP + (id >> 3); e.j = id & 7; } }
    else if (q < Q_BR) { const int t = q - Q_SM; int k; if (t < 64) { e.p = 4 * x + (t >> 4); k = t & 15; } else { const int id = 8 * x + (t - 64); e.p = NPP + (id >> 4); k = id & 15; }
        e.kind = k < 8 ? K_PG : K_SG; e.j = k & 7; }
    else { const int t = (q < Q_OUT) ? q - Q_BR : q - Q_OUT; e.kind = (q < Q_OUT) ? K_BR : K_OUT;
        if (t < 64) { e.j = t >> 2; e.p = 4 * x + (t & 3); } else { const int id = 8 * x + (t - 64); e.p = NPP + (id >> 4); e.j = id & 15; } }
    return e;
}

enum { T_P1A = 0, T_P1V, T_P1GA, T_P1UG, T_P1SEL, T_PG, T_SG, T_BRA, T_BRB, T_OUT };
struct GOps { unsigned offA, offB, lda, ldb; int nt; };
struct GUnit { int type, l, p, j; };
__device__ __forceinline__ GUnit unit_of(int l, const Ent& e, int sub) {
    GUnit u; u.l = l; u.p = e.p; u.j = e.j;
    if (e.kind == K_P1) u.type = e.j < 8 ? T_P1A : e.j < 16 ? T_P1V : e.j < 24 ? T_P1GA : e.j < 40 ? T_P1UG : T_P1SEL;
    else if (e.kind == K_PG) u.type = T_PG; else if (e.kind == K_SG) u.type = T_SG; else if (e.kind == K_BR) u.type = sub ? T_BRB : T_BRA; else u.type = T_OUT;
    return u;
}
__device__ __forceinline__ GOps ops_of(int l, const Ent& e, int sub) {
    GOps u;
    if (e.kind == K_P1) {
        u.offA = (unsigned)(WS_XB + (size_t)e.p * 256 * DM * 2); u.lda = DM * 2;
        u.offB = (unsigned)(WS_WIN + ((size_t)l * INC + (size_t)e.j * 256) * DM * 2); u.ldb = DM * 2; u.nt = DM / 64;
    } else if (e.kind == K_PG) {
        const int g = e.j >> 1;
        u.offA = (unsigned)(WS_POOLED + ((size_t)e.p * 256 * PW + g * 512) * 2); u.lda = PW * 2;
        u.offB = (unsigned)(WS_PWT + ((size_t)((l * 4 + g) * 512 + (e.j & 1) * 256) * 512) * 2); u.ldb = 512 * 2; u.nt = 8;
    } else if (e.kind == K_SG) {
        u.offA = (unsigned)(WS_WBLK + (size_t)(((l * 8 + e.j) * 2 + (e.p >= NPP ? 1 : 0)) * 65536) * 2); u.lda = 256 * 2;
        u.offB = (unsigned)(WS_VNT + ((size_t)(e.j * 256) * MR + (size_t)e.p * 256) * 2); u.ldb = MR * 2; u.nt = 4;
    } else if (e.kind == K_BR) {
        u.offA = (unsigned)(WS_YCAT + ((size_t)e.p * 256 * DM + sub * 2048) * 2); u.lda = DM * 2;
        u.offB = (unsigned)(WS_WBR + (((size_t)l * DM + (size_t)e.j * 256) * DM + sub * 2048) * 2); u.ldb = DM * 2; u.nt = 32;
    } else {
        u.offA = (unsigned)(WS_MERGED + (size_t)e.p * 256 * DM * 2); u.lda = DM * 2;
        u.offB = (unsigned)(WS_WO + ((size_t)l * DM + (size_t)e.j * 256) * DM * 2); u.ldb = DM * 2; u.nt = 64;
    }
    return u;
}
static_assert(WS_END < (1ull << 32), "GEMM operand offsets are 32-bit");

typedef f32x4 Acc[2][2][4][2];
__device__ __forceinline__ u32x4 pack8(const f32x4 a, const f32x4 b) { u32x4 w; w.x = cvt_pk_bf16(a[0], a[1]); w.y = cvt_pk_bf16(a[2], a[3]); w.z = cvt_pk_bf16(b[0], b[1]); w.w = cvt_pk_bf16(b[2], b[3]); return w; }
__device__ __forceinline__ void unpack8(const u32x4 w, f32x4& a, f32x4& b) { a = (f32x4){bf_lo(w.x), bf_hi(w.x), bf_lo(w.y), bf_hi(w.y)}; b = (f32x4){bf_lo(w.z), bf_hi(w.z), bf_lo(w.w), bf_hi(w.w)}; }
#define ST16(ptr, val) (*(u32x4*)(ptr) = (val))
#define ST16F(ptr, val) (*(f32x4*)(ptr) = (val))
#define LD16(ptr) (*(const u32x4*)(ptr))
#define LD16F(ptr) (*(const f32x4*)(ptr))
#define EPI_ROWS(ai, m) _Pragma("unroll") for (int ai = 0; ai < 2; ++ai) _Pragma("unroll") for (int m = 0; m < 4; ++m)
#define ROWOFF(ai, m) ((ai) * 128 + (m) * 16)
#define EPI_FENCE() asm volatile("" ::: "memory")

__device__ __forceinline__ void epi_p1(const Params& P, const Acc& acc, const GUnit& u, int wr, int rl0, int cb) {
    unsigned char* ws = P.ws;
    const char* ssq = (const char*)((const float*)(ws + WS_CTL) + CW_SUMSQ + (size_t)u.l * MR + (size_t)u.p * 256);
    const unsigned vo_s = (unsigned)rl0 * 4u;
    float rs[2][4];
    EPI_ROWS(ai, m) rs[ai][m] = 1.0f / sqrtf(*(const float*)(ssq + ROWOFF(ai, m) * 4 + vo_s) * (1.0f / DM) + EPS);
    const unsigned vo_pw = (unsigned)(rl0 * PW + cb) * 2u, vo_dm = (unsigned)(rl0 * DM + cb) * 2u;
    if (u.type == T_P1A) {
        char* dst = (char*)((bf16*)(ws + WS_A) + (size_t)u.p * 256 * PW + u.j * 256);
        const int fr = rl0 & 15;
        EPI_ROWS(ai, m) {
            const float r = rs[ai][m];
#pragma unroll
            for (int bj = 0; bj < 2; ++bj) {
                const f32x4 v0 = acc[ai][bj][m][0] * r, v1 = acc[ai][bj][m][1] * r;
                const u32x4 w = pack8(v0, v1);
                ST16(dst + (size_t)ROWOFF(ai, m) * PW * 2 + bj * 256 + vo_pw, w);
                if (ai == 1 && m == 3) {
                    if (wr == 1 && fr >= 1) {
                        const unsigned vo_h = (unsigned)((fr - 1) * PW + cb) * 2u;
                        ST16((char*)((bf16*)(ws + WS_HALO) + (size_t)(u.l * NPAN + u.p) * 15 * PW + u.j * 256) + bj * 256 + vo_h, w);
                        if (u.p < NPP && (u.p & 7) == 7) { char* o = (char*)(P.out + O_SPP + (size_t)(u.l * NBATCH + (u.p >> 3)) * 15 * PW + u.j * 256) + bj * 512 + 2 * vo_h; ST16F(o, v0); ST16F(o + 16, v1); }
                    }
                }
                if (u.p >= NPP) {
                    const unsigned vo_o = (unsigned)(((rl0 >> 3) * 15 + (rl0 & 7)) * PW + cb) * 4u;
                    char* o = (char*)(P.out + O_SPS + ((size_t)(u.l * DBATCH + (u.p - NPP) * 32 + ROWOFF(ai, m) / 8) * 15 + 7) * PW + u.j * 256) + bj * 512 + vo_o; ST16F(o, v0); ST16F(o + 16, v1);
                }
            }
            EPI_FENCE();
        }
    } else if (u.type == T_P1V || u.type == T_P1GA) {
        char* dst = (char*)((bf16*)(ws + (u.type == T_P1V ? WS_V : WS_SGA)) + (size_t)u.p * 256 * PW + (u.type == T_P1V ? u.j - 8 : u.j - 16) * 256);
        const bool act = u.type == T_P1GA;
        EPI_ROWS(ai, m) {
            const float r = rs[ai][m];
#pragma unroll
            for (int bj = 0; bj < 2; ++bj) {
                f32x4 v0 = acc[ai][bj][m][0] * r, v1 = acc[ai][bj][m][1] * r;
                if (act) {
#pragma unroll
                    for (int k = 0; k < 4; ++k) { v0[k] = silu_f(v0[k]); v1[k] = silu_f(v1[k]); }
                }
                ST16(dst + (size_t)ROWOFF(ai, m) * PW * 2 + bj * 256 + vo_pw, pack8(v0, v1));
            }
            EPI_FENCE();
        }
    } else if (u.type == T_P1UG) {
        char* dst = (char*)((bf16*)(ws + WS_UG) + (size_t)u.p * 256 * PW + (u.j - 24) * 128);
        EPI_ROWS(ai, m) {
            const float r = rs[ai][m];
            f32x4 o0, o1;
#pragma unroll
            for (int k = 0; k < 4; ++k) { o0[k] = acc[ai][0][m][0][k] * r * silu_f(acc[ai][1][m][0][k] * r); o1[k] = acc[ai][0][m][1][k] * r * silu_f(acc[ai][1][m][1][k] * r); }
            ST16(dst + (size_t)ROWOFF(ai, m) * PW * 2 + vo_pw, pack8(o0, o1));
            EPI_FENCE();
        }
    } else {
        char* dr = (char*)((bf16*)(ws + WS_RATIO) + (size_t)u.p * 256 * DM + (u.j - 40) * 128);
        char* ds = (char*)((bf16*)(ws + WS_SIGB) + (size_t)u.p * 256 * DM + (u.j - 40) * 128);
        EPI_ROWS(ai, m) {
            const float r = rs[ai][m];
            f32x4 q0, q1, s0, s1;
#pragma unroll
            for (int k = 0; k < 4; ++k) {
                q0[k] = fast_rcp(1.0f + fast_exp(-acc[ai][0][m][0][k] * r)); s0[k] = fast_rcp(1.0f + fast_exp(-acc[ai][1][m][0][k] * r));
                q1[k] = fast_rcp(1.0f + fast_exp(-acc[ai][0][m][1][k] * r)); s1[k] = fast_rcp(1.0f + fast_exp(-acc[ai][1][m][1][k] * r));
            }
            ST16(dr + (size_t)ROWOFF(ai, m) * DM * 2 + vo_dm, pack8(q0, q1)); ST16(ds + (size_t)ROWOFF(ai, m) * DM * 2 + vo_dm, pack8(s0, s1));
            EPI_FENCE();
        }
    }
}

__device__ __forceinline__ void epi_pg(const Params& P, const Acc& acc, const GUnit& u, int rl0, int cb) {
    unsigned char* ws = P.ws;
    const unsigned vo_pw = (unsigned)(rl0 * PW + cb) * 2u, vo_dm = (unsigned)(rl0 * DM + cb) * 2u, vo_c = (unsigned)cb * 4u;
    const char* sc = (const char*)(P.in[I_PSCALE] + (size_t)u.l * PW + u.j * 256);
    f32x4 s[2][2];
#pragma unroll
    for (int bj = 0; bj < 2; ++bj) { s[bj][0] = LD16F(sc + bj * 512 + vo_c); s[bj][1] = LD16F(sc + bj * 512 + 16 + vo_c); }
    const char* ga = (const char*)((const bf16*)(ws + WS_SGA) + (size_t)u.p * 256 * PW + u.j * 256);
    char* dst = (char*)((bf16*)(ws + WS_YCAT) + (size_t)u.p * 256 * DM + u.j * 256);
    EPI_ROWS(ai, m) {
#pragma unroll
        for (int bj = 0; bj < 2; ++bj) {
            f32x4 g0, g1; unpack8(LD16(ga + (size_t)ROWOFF(ai, m) * PW * 2 + bj * 256 + vo_pw), g0, g1);
            ST16(dst + (size_t)ROWOFF(ai, m) * DM * 2 + bj * 256 + vo_dm, pack8(acc[ai][bj][m][0] * s[bj][0] * g0, acc[ai][bj][m][1] * s[bj][1] * g1));
        }
        EPI_FENCE();
    }
}
__device__ __forceinline__ void epi_sg(const Params& P, const Acc& acc, const GUnit& u, int rl0, int cb) {
    unsigned char* ws = P.ws;
    const unsigned vo_pw = (unsigned)(rl0 * PW + cb) * 2u, vo_dm = (unsigned)(rl0 * DM + cb) * 2u;
    const char* bs = (const char*)(P.in[I_SGUB] + (size_t)(u.l * 8 + u.j) * 128);
    const int tmask = u.p < NPP ? 127 : 7;
    const char* ug = (const char*)((const bf16*)(ws + WS_UG) + (size_t)u.p * 256 * PW + u.j * 256);
    char* dst = (char*)((bf16*)(ws + WS_YCAT) + (size_t)u.p * 256 * DM + 2048 + u.j * 256);
    EPI_ROWS(ai, m) {
        const float b = *(const float*)(bs + (unsigned)(((rl0 + ROWOFF(ai, m)) & tmask) * 4));
#pragma unroll
        for (int bj = 0; bj < 2; ++bj) {
            f32x4 g0, g1; unpack8(LD16(ug + (size_t)ROWOFF(ai, m) * PW * 2 + bj * 256 + vo_pw), g0, g1);
            ST16(dst + (size_t)ROWOFF(ai, m) * DM * 2 + bj * 256 + vo_dm, pack8((acc[ai][bj][m][0] + b) * g0, (acc[ai][bj][m][1] + b) * g1));
        }
        EPI_FENCE();
    }
}
__device__ __forceinline__ void epi_br(const Params& P, const Acc& acc, const GUnit& u, int rl0, int cb) {
    unsigned char* ws = P.ws;
    const unsigned vo_dm = (unsigned)(rl0 * DM + cb) * 2u, vo_f = 2u * vo_dm;
    const char* src = (const char*)((const bf16*)(ws + (u.type == T_BRA ? WS_RATIO : WS_SIGB)) + (size_t)u.p * 256 * DM + u.j * 256);
    char* tmp = (char*)((float*)(ws + WS_TMP) + (size_t)u.p * 256 * DM + u.j * 256);
    char* dst = (char*)((bf16*)(ws + WS_MERGED) + (size_t)u.p * 256 * DM + u.j * 256);
    if (u.type == T_BRA) {
        EPI_ROWS(ai, m) {
#pragma unroll
            for (int bj = 0; bj < 2; ++bj) {
                f32x4 g0, g1; unpack8(LD16(src + (size_t)ROWOFF(ai, m) * DM * 2 + bj * 256 + vo_dm), g0, g1);
                ST16F(tmp + (size_t)ROWOFF(ai, m) * DM * 4 + bj * 512 + vo_f, acc[ai][bj][m][0] * g0); ST16F(tmp + (size_t)ROWOFF(ai, m) * DM * 4 + bj * 512 + 16 + vo_f, acc[ai][bj][m][1] * g1);
            }
            EPI_FENCE();
        }
    } else {
        EPI_ROWS(ai, m) {
#pragma unroll
            for (int bj = 0; bj < 2; ++bj) {
                f32x4 g0, g1; unpack8(LD16(src + (size_t)ROWOFF(ai, m) * DM * 2 + bj * 256 + vo_dm), g0, g1);
                const f32x4 t0 = LD16F(tmp + (size_t)ROWOFF(ai, m) * DM * 4 + bj * 512 + vo_f), t1 = LD16F(tmp + (size_t)ROWOFF(ai, m) * DM * 4 + bj * 512 + 16 + vo_f);
                ST16(dst + (size_t)ROWOFF(ai, m) * DM * 2 + bj * 256 + vo_dm, pack8(t0 + acc[ai][bj][m][0] * g0, t1 + acc[ai][bj][m][1] * g1));
            }
            EPI_FENCE();
        }
    }
}
__device__ __forceinline__ void epi_out(const Params& P, const Acc& acc, const GUnit& u, int rl0, int cb) {
    unsigned char* ws = P.ws;
    const unsigned vo_b = (unsigned)(rl0 * DM + cb) * 2u, vo_f = 2u * vo_b, vo_s = (unsigned)rl0 * 4u;
    const char* xin = (const char*)((u.l == 0) ? (u.p < NPP ? P.in[I_XP] + (size_t)u.p * 256 * DM : P.in[I_XS] + (size_t)(u.p - NPP) * 256 * DM) : (const float*)(ws + WS_XF) + (size_t)u.p * 256 * DM) + (size_t)u.j * 1024;
    char* xf = (char*)((float*)(ws + WS_XF) + (size_t)u.p * 256 * DM + u.j * 256);
    char* xb = (char*)((bf16*)(ws + WS_XB) + (size_t)u.p * 256 * DM + u.j * 256);
    char* ssq = (char*)((float*)(ws + WS_CTL) + CW_SUMSQ + (size_t)(u.l + 1) * MR + (size_t)u.p * 256);
    const bool lead = ((cb >> 3) & 3) == 0;
    EPI_ROWS(ai, m) {
        float ss = 0.f;
#pragma unroll
        for (int bj = 0; bj < 2; ++bj) {
            const f32x4 x0 = LD16F(xin + (size_t)ROWOFF(ai, m) * DM * 4 + bj * 512 + vo_f) + acc[ai][bj][m][0], x1 = LD16F(xin + (size_t)ROWOFF(ai, m) * DM * 4 + bj * 512 + 16 + vo_f) + acc[ai][bj][m][1];
            ST16F(xf + (size_t)ROWOFF(ai, m) * DM * 4 + bj * 512 + vo_f, x0); ST16F(xf + (size_t)ROWOFF(ai, m) * DM * 4 + bj * 512 + 16 + vo_f, x1);
            ST16(xb + (size_t)ROWOFF(ai, m) * DM * 2 + bj * 256 + vo_b, pack8(x0, x1));
            ss += (x0[0] * x0[0] + x0[1] * x0[1]) + (x0[2] * x0[2] + x0[3] * x0[3]) + (x1[0] * x1[0] + x1[1] * x1[1]) + (x1[2] * x1[2] + x1[3] * x1[3]);
        }
        ss += __shfl_xor(ss, 16); ss += __shfl_xor(ss, 32);
        if (lead) atomicAdd((float*)(ssq + ROWOFF(ai, m) * 4 + vo_s), ss);
        EPI_FENCE();
    }
}

#define G_SA(b, h) (((b) * 2 + (h)) * HTB)
#define G_SB(b, h) ((4 + (b) * 2 + (h)) * HTB)
#define G_STAGE(bufoff, off32, r64, voff) do { \
        __builtin_amdgcn_global_load_lds((const unsigned*)(wsb + (unsigned)((off32) + (voff))), (LAS unsigned*)(lds + (bufoff) + ldsw), 16, 0, 0); \
        __builtin_amdgcn_global_load_lds((const unsigned*)(wsb + (unsigned)((off32) + (r64) + (voff))), (LAS unsigned*)(lds + (bufoff) + ldsw + 8192), 16, 0, 0); } while (0)
#define G_LDA(dst, b, h) do { _Pragma("unroll") for (int m = 0; m < 4; ++m) _Pragma("unroll") for (int k = 0; k < 2; ++k) dst[m][k] = *(const LAS bf16x8*)(lds + G_SA(b, h) + aoff + m * 2048 + k * 1024); } while (0)
#define G_LDB(dst, b, h) do { _Pragma("unroll") for (int n = 0; n < 2; ++n) _Pragma("unroll") for (int k = 0; k < 2; ++k) dst[n][k] = *(const LAS bf16x8*)(lds + G_SB(b, h) + boff + n * 2048 + k * 1024); } while (0)
#define G_MMA(ai, bj, At, Bt) do { __builtin_amdgcn_s_setprio(1); _Pragma("unroll") for (int m = 0; m < 4; ++m) _Pragma("unroll") for (int n = 0; n < 2; ++n) _Pragma("unroll") for (int k = 0; k < 2; ++k) \
        acc[ai][bj][m][n] = __builtin_amdgcn_mfma_f32_16x16x32_bf16(Bt[n][k], At[m][k], acc[ai][bj][m][n], 0, 0, 0); __builtin_amdgcn_s_setprio(0); } while (0)
#define G_WAIT_V(n) asm volatile("s_waitcnt vmcnt(" #n ")" ::: "memory")
#define G_WAIT_L(n) asm volatile("s_waitcnt lgkmcnt(" #n ")" ::: "memory")
#define G_BAR __builtin_amdgcn_s_barrier()
#define G_SCHED __builtin_amdgcn_sched_barrier(0)

__device__ __forceinline__ void gemm_stream(const Params& P, const Ctx& C, int l, int q, int qend) {
    LAS unsigned char* lds = C.lds;
    const char* wsb = (const char*)P.ws;
    int lane = C.lane; asm volatile("" : "+v"(lane));
    const int wid = C.wid, wr = wid >> 2, wc = wid & 3, fr = lane & 15, fq = lane >> 4;
#define G_SRC() int _tz = lane; asm volatile("" : "+v"(_tz)); const int _sb = _tz * 16, _swz = _sb ^ (((_sb >> 9) & 1) << 5); \
        const unsigned sR = (unsigned)((wid >> 1) * 16 + _swz / 64), sC2 = (unsigned)(((wid & 1) * 32 + (_swz % 64) / 2) * 2)
    const unsigned ldsw = (unsigned)wid * 1024u;
    const int aoff = lds_byte(wr * 64 + fr, fq * 8), boff = lds_byte(wc * 32 + fr, fq * 8);
    int sub = 0;
    GOps cur;
    { const Ent e = decode_ent(q, C.xcd); cur = ops_of(l, e, 0); }
    Acc acc;
#pragma unroll
    for (int a = 0; a < 2; ++a)
#pragma unroll
        for (int b = 0; b < 2; ++b)
#pragma unroll
            for (int m = 0; m < 4; ++m)
#pragma unroll
                for (int n = 0; n < 2; ++n) acc[a][b][m][n] = (f32x4){0.f, 0.f, 0.f, 0.f};
    bf16x8 At[4][2], B0[2][2], B1[2][2];
    unsigned cA = cur.offA, cB = cur.offB, rA = cur.lda * 64u, rB = cur.ldb * 64u;
    unsigned voffA, voffB;
    { G_SRC(); voffA = sR * cur.lda + sC2; voffB = sR * cur.ldb + sC2; }
    int nt = cur.nt;
    G_STAGE(G_SB(0, 0), cB, rB, voffB); G_STAGE(G_SB(0, 1), cB + 2 * rB, rB, voffB); G_STAGE(G_SA(0, 0), cA, rA, voffA); G_STAGE(G_SA(0, 1), cA + 2 * rA, rA, voffA);
    if (wr == 1) G_BAR;
    G_WAIT_V(2); G_BAR;
    G_STAGE(G_SB(1, 0), cB + 128, rB, voffB); G_STAGE(G_SA(1, 0), cA + 128, rA, voffA); G_STAGE(G_SB(1, 1), cB + 2 * rB + 128, rB, voffB);
    G_WAIT_V(6); G_BAR;
    for (;;) {
        bool has_next = true;
        unsigned a2 = cA + 256, b2 = cB + 256, rA2 = rA, rB2 = rB, vA2 = voffA, vB2 = voffB; int nnt = nt;
        for (int t = 0; t < nt; t += 2) {
            if (t == nt - 2) {
                int qn = q, subn = 0; Ent en = decode_ent(q, C.xcd);
                if (en.kind == K_BR && sub == 0) subn = 1; else { qn = q + C.W; has_next = qn < qend; if (has_next) en = decode_ent(qn, C.xcd); }
                if (has_next) { G_SRC(); const GOps nx = ops_of(l, en, subn); a2 = nx.offA; b2 = nx.offB; rA2 = nx.lda * 64u; rB2 = nx.ldb * 64u; vA2 = sR * nx.lda + sC2; vB2 = sR * nx.ldb + sC2; nnt = nx.nt; }
                else { a2 = cA; b2 = cB; }
            }
            const unsigned a1 = cA + (unsigned)(t + 1) * 128u;
            G_LDB(B0, 0, 0); G_LDB(B1, 0, 1); G_SCHED; G_LDA(At, 0, 0); G_STAGE(G_SA(1, 1), a1 + 2 * rA, rA, voffA);
            G_WAIT_V(8); G_WAIT_L(0); G_BAR; G_MMA(0, 0, At, B0); G_MMA(0, 1, At, B1); G_BAR; G_SCHED;
            G_LDA(At, 0, 1); G_STAGE(G_SB(0, 0), b2, rB2, vB2); G_STAGE(G_SB(0, 1), b2 + 2 * rB2, rB2, vB2); G_STAGE(G_SA(0, 0), a2, rA2, vA2);
            G_WAIT_V(8); G_WAIT_L(0); G_BAR; G_MMA(1, 0, At, B0); G_MMA(1, 1, At, B1); G_BAR; G_SCHED;
            G_LDB(B0, 1, 0); G_LDB(B1, 1, 1); G_SCHED; G_LDA(At, 1, 0); G_STAGE(G_SA(0, 1), a2 + 2 * rA2, rA2, vA2);
            G_WAIT_V(8); G_WAIT_L(0); G_BAR; G_MMA(0, 0, At, B0); G_MMA(0, 1, At, B1); G_BAR; G_SCHED;
            G_LDA(At, 1, 1); G_STAGE(G_SB(1, 0), b2 + 128, rB2, vB2); G_STAGE(G_SB(1, 1), b2 + 128 + 2 * rB2, rB2, vB2); G_STAGE(G_SA(1, 0), a2 + 128, rA2, vA2);
            G_WAIT_V(8); G_WAIT_L(0); G_BAR; G_MMA(1, 0, At, B0); G_MMA(1, 1, At, B1); G_BAR; G_SCHED;
            a2 += 256; b2 += 256;
        }
        if (wr == 0) G_BAR;
        const Ent ec = decode_ent(q, C.xcd);
        const GUnit u = unit_of(l, ec, sub);
        int e_rl0 = wr * 64 + fr, e_cb = wc * 32 + fq * 8;
        asm volatile("" : "+v"(e_rl0), "+v"(e_cb));
        switch (u.type) {
            case T_PG: epi_pg(P, acc, u, e_rl0, e_cb); break;
            case T_SG: epi_sg(P, acc, u, e_rl0, e_cb); break;
            case T_BRA: case T_BRB: epi_br(P, acc, u, e_rl0, e_cb); break;
            case T_OUT: epi_out(P, acc, u, e_rl0, e_cb); break;
            default: epi_p1(P, acc, u, wr, e_rl0, e_cb); break;
        }
        if (!has_next) break;
#pragma unroll
        for (int a = 0; a < 2; ++a)
#pragma unroll
            for (int b = 0; b < 2; ++b)
#pragma unroll
                for (int m = 0; m < 4; ++m)
#pragma unroll
                    for (int n = 0; n < 2; ++n) acc[a][b][m][n] = (f32x4){0.f, 0.f, 0.f, 0.f};
        if (ec.kind == K_BR && sub == 0) sub = 1; else { q += C.W; sub = 0; }
        cA = a2 - 256; cB = b2 - 256; rA = rA2; rB = rB2; voffA = vA2; voffB = vB2; nt = nnt;
        if (wr == 1) G_BAR;
    }
    G_WAIT_V(0);
    G_BAR;
}

__device__ __forceinline__ f32x4 ld_bf4(const bf16* p) { const u32x2 w = *(const u32x2*)p; return (f32x4){bf_lo(w.x), bf_hi(w.x), bf_lo(w.y), bf_hi(w.y)}; }
__device__ __forceinline__ void pv_unit(const Params& P, const Ctx& C, int l, int p, int blk) {
    unsigned char* ws = P.ws;
    int tid = C.tid; asm volatile("" : "+v"(tid));
    const int lane = tid & 63, wid = C.wid;
    const int row0 = 256 * p + 32 * blk;
    const bf16* abuf = (const bf16*)(ws + WS_A);
    bf16* pooled = (bf16*)(ws + WS_POOLED);
    {
        const int c0 = 4 * tid, w = 2 << (tid >> 7);
        const float rw = 1.0f / (float)w;
        if (p < NPP) {
            const int sp0 = row0 & (SEQ - 1);
            const bf16* halo = (const bf16*)(ws + WS_HALO) + ((size_t)(l * NPAN + p - 1) * 15) * PW;
            f32x4 S = (f32x4){0.f, 0.f, 0.f, 0.f};
            for (int k = 1; k < w; ++k) {
                if (sp0 - k >= 0) S += (blk == 0) ? ld_bf4(halo + (size_t)(15 - k) * PW + c0) : ld_bf4(abuf + (size_t)(row0 - k) * PW + c0);
            }
#pragma unroll 4
            for (int t = 0; t < 32; ++t) {
                const f32x4 x = ld_bf4(abuf + (size_t)(row0 + t) * PW + c0);
                S += x;
                const int pos = sp0 + t; const float rc = (pos + 1 < w) ? 1.0f / (float)(pos + 1) : rw;
                const f32x4 o = S * rc - x;
                u32x2 pk; pk.x = cvt_pk_bf16(o[0], o[1]); pk.y = cvt_pk_bf16(o[2], o[3]);
                *(u32x2*)(pooled + (size_t)(row0 + t) * PW + c0) = pk;
                const int tt = t - w + 1;
                if (sp0 + tt >= 0) S -= (tt >= 0 || blk != 0) ? ld_bf4(abuf + (size_t)(row0 + tt) * PW + c0) : ld_bf4(halo + (size_t)(15 + tt) * PW + c0);
            }
        } else {
            const int srow0 = row0 - MP;
#pragma unroll 1
            for (int s = 0; s < 4; ++s) {
                const int b = (srow0 >> 3) + s;
                const float* st = P.in[I_STATE] + ((size_t)(l * DBATCH + b) * 15) * PW + c0;
                const bf16* ar = abuf + (size_t)(row0 + 8 * s) * PW + c0;
                f32x4 S = (f32x4){0.f, 0.f, 0.f, 0.f};
                for (int k = 1; k < w; ++k) S += *(const f32x4*)(st + (size_t)(15 - k) * PW);
#pragma unroll
                for (int t = 0; t < 8; ++t) {
                    const f32x4 x = ld_bf4(ar + (size_t)t * PW);
                    S += x;
                    const f32x4 o = S * rw - x;
                    u32x2 pk; pk.x = cvt_pk_bf16(o[0], o[1]); pk.y = cvt_pk_bf16(o[2], o[3]);
                    *(u32x2*)(pooled + (size_t)(row0 + 8 * s + t) * PW + c0) = pk;
                    const int i = 15 + t - w + 1;
                    S -= (i < 15) ? *(const f32x4*)(st + (size_t)i * PW) : ld_bf4(ar + (size_t)(i - 15) * PW);
                }
            }
        }
    }
    LAS float* rstd_s = (LAS float*)C.lds;
    const bf16* vbuf = (const bf16*)(ws + WS_V);
    const float* gv = P.in[I_SGUG] + (size_t)l * PW;
#pragma unroll 1
    for (int rr = 0; rr < 4; ++rr) {
        const int r = row0 + 4 * wid + rr;
        u32x4 wv[4]; float ss = 0.f;
#pragma unroll
        for (int k = 0; k < 4; ++k) { wv[k] = *(const u32x4*)(vbuf + (size_t)r * PW + 8 * lane + 512 * k);
            f32x4 a, b; unpack8(wv[k], a, b); ss += (a[0] * a[0] + a[1] * a[1]) + (a[2] * a[2] + a[3] * a[3]) + (b[0] * b[0] + b[1] * b[1]) + (b[2] * b[2] + b[3] * b[3]); }
        const float rstd = 1.0f / sqrtf(wave_sum(ss) * (1.0f / PW) + EPS);
        if (lane == 0) rstd_s[4 * wid + rr] = rstd;
        if (p >= NPP) {
            float* o = P.out + O_SGV + ((size_t)l * MS + (size_t)(r - MP)) * PW;
#pragma unroll
            for (int k = 0; k < 4; ++k) { f32x4 a, b; unpack8(wv[k], a, b); const int c = 8 * lane + 512 * k;
                *(f32x4*)(o + c) = a * rstd * *(const f32x4*)(gv + c); *(f32x4*)(o + c + 4) = b * rstd * *(const f32x4*)(gv + c + 4); }
        }
    }
    LDS_WAIT(); __syncthreads();
    bf16* vnt = (bf16*)(ws + WS_VNT);
#pragma unroll 1
    for (int k = 0; k < 2; ++k) {
        const int c = 2 * (tid + 512 * k);
        const float g0 = gv[c], g1 = gv[c + 1];
        unsigned o0[16], o1[16];
#pragma unroll
        for (int r2 = 0; r2 < 16; ++r2) {
            const unsigned wa = *(const unsigned*)(vbuf + (size_t)(row0 + 2 * r2) * PW + c), wb = *(const unsigned*)(vbuf + (size_t)(row0 + 2 * r2 + 1) * PW + c);
            const float ra = rstd_s[2 * r2], rb = rstd_s[2 * r2 + 1];
            o0[r2] = cvt_pk_bf16(bf_lo(wa) * ra * g0, bf_lo(wb) * rb * g0); o1[r2] = cvt_pk_bf16(bf_hi(wa) * ra * g1, bf_hi(wb) * rb * g1);
        }
        const int slot = (c & ~31) + invperm32(c & 31);
        u32x4* d0 = (u32x4*)(vnt + (size_t)slot * MR + row0); u32x4* d1 = (u32x4*)(vnt + (size_t)(slot + 1) * MR + row0);
#pragma unroll
        for (int i = 0; i < 4; ++i) { d0[i] = (u32x4){o0[4 * i], o0[4 * i + 1], o0[4 * i + 2], o0[4 * i + 3]}; d1[i] = (u32x4){o1[4 * i], o1[4 * i + 1], o1[4 * i + 2], o1[4 * i + 3]}; }
    }
    __syncthreads();
}

__device__ __forceinline__ void fin_unit(const Params& P, const Ctx& C, int p, int blk) {
    unsigned char* ws = P.ws;
    const float* gf = P.in[I_FING];
    const float* ssq = (const float*)(ws + WS_CTL) + CW_SUMSQ + (size_t)DEPTH * MR;
    int lane = C.lane; asm volatile("" : "+v"(lane));
#pragma unroll 1
    for (int rr = 0; rr < 4; ++rr) {
        const int r = 256 * p + 32 * blk + 4 * C.wid + rr;
        const float rstd = 1.0f / sqrtf(ssq[r] * (1.0f / DM) + EPS);
        const f32x4* x = (const f32x4*)((const float*)(ws + WS_XF) + (size_t)r * DM) + lane;
        f32x4* o = (f32x4*)(P.out + O_Y + (size_t)r * DM) + lane;
#pragma unroll 4
        for (int k = 0; k < 16; ++k) o[64 * k] = x[64 * k] * rstd * ((const f32x4*)gf)[lane + 64 * k];
    }
}

__device__ __forceinline__ void tr_item(const float* W, size_t ldn, int k0, int n0s, bf16* WT, size_t ldk, size_t drow0, int kd0, const float* gk, LAS float* scr, int lane) {
#pragma unroll 8
    for (int i = 0; i < 32; ++i) { const int kk = 2 * i + (lane >> 5); float v = W[(size_t)(k0 + kk) * ldn + n0s + (lane & 31)]; if (gk) v *= gk[k0 + kk]; scr[kk * 33 + (lane & 31)] = v; }
    LDS_WAIT(); asm volatile("" ::: "memory");
    const int c = lane & 7;
#pragma unroll
    for (int j = 0; j < 4; ++j) { const int n = (lane >> 3) + 8 * j; const LAS float* s = scr + (8 * c) * 33 + n;
        u32x4 o; o.x = cvt_pk_bf16(s[0 * 33], s[1 * 33]); o.y = cvt_pk_bf16(s[2 * 33], s[3 * 33]); o.z = cvt_pk_bf16(s[4 * 33], s[5 * 33]); o.w = cvt_pk_bf16(s[6 * 33], s[7 * 33]);
        *(u32x4*)(WT + (drow0 + invperm32(n)) * ldk + kd0 + 8 * c) = o; }
    LDS_WAIT(); asm volatile("" ::: "memory");
}
__device__ __forceinline__ int win_src_col(int v) {
    const int j = v >> 8, c = v & 255;
    if (j < 8) return v;
    if (j < 16) return 6144 + (v - 2048);
    if (j < 24) return 2048 + (v - 4096);
    if (j < 40) { const int t = j - 24; return c < 128 ? 4096 + 128 * t + c : 8192 + 128 * t + (c - 128); }
    { const int t = j - 40; return c < 128 ? 10240 + 128 * t + c : 14336 + 128 * t + (c - 128); }
}
__device__ __forceinline__ void prologue(const Params& P, const Ctx& C) {
    unsigned char* ws = P.ws;
    LAS float* scr = (LAS float*)(C.lds + C.wid * 16384);
    const int vcu = C.xcd * C.W + C.rank;
    const long gw = (long)vcu * 8 + C.wid, NGW = (long)C.G * 8;
    int lane = C.lane; asm volatile("" : "+v"(lane));
    constexpr long N_WIN = (long)DEPTH * 64 * 576, N_WBR = (long)DEPTH * 2 * 32 * 128, N_WO = (long)DEPTH * 64 * 128, N_PW = (long)DEPTH * 4 * 8 * 16;
    constexpr long N_TR = N_WIN + N_WBR + N_WO + N_PW;
    for (long it = gw; it < N_TR; it += NGW) {
        long r = it;
        if (r < N_WIN) { const int l = (int)(r / 36864), r2 = (int)(r % 36864), kb = r2 / 576, vg = r2 % 576;
            tr_item(P.in[I_WIN] + (size_t)l * DM * INC, INC, 64 * kb, win_src_col(32 * vg), (bf16*)(ws + WS_WIN), DM, (size_t)l * INC + 32 * vg, 64 * kb, P.in[I_NORMG] + (size_t)l * DM, scr, lane); continue; }
        r -= N_WIN;
        if (r < N_WBR) { const int l = (int)(r / 8192), r2 = (int)(r % 8192), ab = r2 / 4096, r3 = r2 % 4096, kb = r3 / 128, vg = r3 % 128;
            tr_item(P.in[ab ? I_WBB : I_WBA] + (size_t)l * PW * DM, DM, 64 * kb, 32 * vg, (bf16*)(ws + WS_WBR), DM, (size_t)l * DM + 32 * vg, 64 * kb + ab * 2048, nullptr, scr, lane); continue; }
        r -= N_WBR;
        if (r < N_WO) { const int l = (int)(r / 8192), r2 = (int)(r % 8192), kb = r2 / 128, vg = r2 % 128;
            tr_item(P.in[I_WOUT] + (size_t)l * DM * DM, DM, 64 * kb, 32 * vg, (bf16*)(ws + WS_WO), DM, (size_t)l * DM + 32 * vg, 64 * kb, nullptr, scr, lane); continue; }
        r -= N_WO;
        { const int lg = (int)(r / 128), r2 = (int)(r % 128), kb = r2 / 16, vg = r2 % 16;
            tr_item(P.in[I_POOLW] + (size_t)lg * 512 * 512, 512, 64 * kb, 32 * vg, (bf16*)(ws + WS_PWT), 512, (size_t)lg * 512 + 32 * vg, 64 * kb, nullptr, scr, lane); }
    }
    for (long m = gw; m < MR; m += NGW) {
        const float* x = (m < MP) ? P.in[I_XP] + (size_t)m * DM : P.in[I_XS] + (size_t)(m - MP) * DM;
        bf16* xb = (bf16*)(ws + WS_XB) + (size_t)m * DM; float ss = 0.f;
#pragma unroll 4
        for (int k = 0; k < 8; ++k) { const f32x4 a = *(const f32x4*)(x + 8 * lane + 512 * k), b = *(const f32x4*)(x + 8 * lane + 512 * k + 4);
            ss += (a[0] * a[0] + a[1] * a[1]) + (a[2] * a[2] + a[3] * a[3]) + (b[0] * b[0] + b[1] * b[1]) + (b[2] * b[2] + b[3] * b[3]);
            *(u32x4*)(xb + 8 * lane + 512 * k) = pack8(a, b); }
        ss = wave_sum(ss);
        if (lane == 0) ((float*)(ws + WS_CTL))[CW_SUMSQ + m] = ss;
    }
    for (long m = gw; m < (long)DEPTH * DBATCH * 7; m += NGW) {
        const long lb = m / 7; const int i = (int)(m % 7);
        const f32x4* s = (const f32x4*)(P.in[I_STATE] + ((size_t)lb * 15 + 8 + i) * PW) + lane; f32x4* o = (f32x4*)(P.out + O_SPS + ((size_t)lb * 15 + i) * PW) + lane;
#pragma unroll
        for (int k = 0; k < 8; ++k) o[64 * k] = s[64 * k];
    }
    for (long m = gw; m < (long)DEPTH * 8 * 2 * 256; m += NGW) {
        const int t = (int)(m & 255), ps = (int)((m >> 8) & 1); const long lh = m >> 9;
        const float* w = P.in[I_SGUW] + (size_t)lh * 128 * 128;
        bf16* o = (bf16*)(ws + WS_WBLK) + (size_t)m * 256;
        u32x2 pk; float v[4];
#pragma unroll
        for (int k = 0; k < 4; ++k) { const int s = 4 * lane + k; float x = 0.f;
            if (ps == 0) { if ((s >> 7) == (t >> 7) && (s & 127) <= (t & 127)) x = w[(t & 127) * 128 + (s & 127)]; }
            else { if ((s >> 3) == (t >> 3) && (s & 7) <= (t & 7)) x = w[(t & 7) * 128 + (s & 7)]; }
            v[k] = x; }
        pk.x = cvt_pk_bf16(v[0], v[1]); pk.y = cvt_pk_bf16(v[2], v[3]);
        *(u32x2*)(o + 4 * lane) = pk;
    }
}

__global__ void __launch_bounds__(512, 2) fwd_kernel(Params P) {
    extern __shared__ __attribute__((aligned(16))) unsigned char lds_raw[];
    Ctx C;
    C.lds = (LAS unsigned char*)lds_raw;
    C.tid = threadIdx.x; C.lane = C.tid & 63; C.wid = __builtin_amdgcn_readfirstlane(C.tid >> 6);
    C.G = gridDim.x; C.W = C.G >> 3; C.xcd = blockIdx.x & 7; C.rank = blockIdx.x >> 3;
    volatile LAS unsigned* MISC = (volatile LAS unsigned*)(C.lds + MISC_OFF);
    if (C.tid < 16) MISC[C.tid] = 0u;
    __syncthreads();
    unsigned* ctl = (unsigned*)(P.ws + WS_CTL);
    const int plo = P.ph_lo, phi = P.ph_hi;
    XcdBarrier bar; bar.bar = ctl + CW_BAR; bar.x = 0; bar.st = MISC + 8;
    if (phi - plo > 1) bar = xcd_barrier_post(ctl + CW_BAR, MISC + 8);
#define IN_PH(k) (plo <= (k) && (k) < phi)
#define SEAM(k) do { if (IN_PH(k) && IN_PH((k) + 1)) xcd_barrier(bar); } while (0)

    if (IN_PH(0)) prologue(P, C);
    SEAM(0);
#pragma unroll 1
    for (int l = 0; l < DEPTH; ++l) {
        const int q0 = (C.rank - 8 * l) & (C.W - 1);
#pragma unroll 1
        for (int ph = 0; ph < 5; ++ph) {
            const int k = 1 + 5 * l + ph;
            if (IN_PH(k)) {
                const int qs = ph == 0 ? Q_P1 : ph == 1 ? Q_PV : ph == 2 ? Q_SM : ph == 3 ? Q_BR : Q_OUT, qe = ph == 0 ? Q_PV : ph == 1 ? Q_SM : ph == 2 ? Q_BR : ph == 3 ? Q_OUT : Q_FIN;
                int q = q0 + ((qs - q0 + C.W - 1) / C.W) * C.W;
                if (ph == 1) { for (; q < qe; q += C.W) { const Ent e = decode_ent(q, C.xcd); pv_unit(P, C, l, e.p, e.j); } }
                else if (q < qe) gemm_stream(P, C, l, q, qe);
            }
            SEAM(k);
        }
    }
    if (IN_PH(21)) { const int q0 = (C.rank - 8 * (DEPTH - 1)) & (C.W - 1);
      int q = q0 + ((Q_FIN - q0 + C.W - 1) / C.W) * C.W; for (; q < Q_END; q += C.W) { const Ent e = decode_ent(q, C.xcd); fin_unit(P, C, e.p, e.j); } }
}

#ifdef DBG_LAST_PHASE
__global__ void dbg_dump(const unsigned short* src, float* dst, size_t n) {
    for (size_t i = (size_t)blockIdx.x * blockDim.x + threadIdx.x; i < n; i += (size_t)gridDim.x * blockDim.x) dst[i] = __uint_as_float(((unsigned)src[i]) << 16);
}
#endif
extern "C" void kernel_launch(void* const* d_in, const int* in_sizes, int n_in, void* d_out, int out_size, void* d_ws, size_t ws_size, hipStream_t stream) {
    static int grid = 0;
    if (grid == 0) {
        if (n_in != 14 || (size_t)out_size != O_END || ws_size < WS_END) { fprintf(stderr, "kernel_launch: unexpected sizes (n_in %d out %d ws %zu need %zu)\n", n_in, out_size, ws_size, (size_t)WS_END); grid = -1; return; }
        int dev = 0, cus = 0, per_cu = 0;
        if (hipGetDevice(&dev) != hipSuccess || hipDeviceGetAttribute(&cus, hipDeviceAttributeMultiprocessorCount, dev) != hipSuccess) { grid = -1; return; }
        if (hipFuncSetAttribute((const void*)fwd_kernel, hipFuncAttributeMaxDynamicSharedMemorySize, LDS_BYTES) != hipSuccess) { fprintf(stderr, "kernel_launch: hipFuncSetAttribute failed\n"); grid = -1; return; }
        if (hipOccupancyMaxActiveBlocksPerMultiprocessor(&per_cu, (const void*)fwd_kernel, 512, LDS_BYTES) != hipSuccess || per_cu < 1) fprintf(stderr, "kernel_launch: occupancy query says %d\n", per_cu);
        (void)hipGetLastError();
        grid = cus;
        if (grid != 256) fprintf(stderr, "kernel_launch: %d CUs (built for 256)\n", grid);
        grid = 256;
    }
    if (grid < 0) return;
    (void)in_sizes;
    if (hipMemsetAsync((char*)d_ws + WS_CTL, 0, CTL_ZERO_BYTES, stream) != hipSuccess) return;
    Params p{};
    for (int i = 0; i < 14; ++i) p.in[i] = (const float*)d_in[i];
    p.out = (float*)d_out; p.ws = (unsigned char*)d_ws;
#if N_LAUNCHES == 1
    p.ph_lo = 0; p.ph_hi = 22;
    hipLaunchKernelGGL(fwd_kernel, dim3(grid), dim3(512), LDS_BYTES, stream, p);
#else
#ifdef DBG_LAST_PHASE
    for (int k = 0; k <= DBG_LAST_PHASE; ++k) { p.ph_lo = k; p.ph_hi = k + 1; hipLaunchKernelGGL(fwd_kernel, dim3(grid), dim3(512), LDS_BYTES, stream, p); }
    hipLaunchKernelGGL(dbg_dump, dim3(2048), dim3(256), 0, stream, (const unsigned short*)((const char*)d_ws + DBG_DUMP_OFF), (float*)d_out, (size_t)DBG_DUMP_N);
#else
    for (int k = 0; k < 22; ++k) { p.ph_lo = k; p.ph_hi = k + 1; hipLaunchKernelGGL(fwd_kernel, dim3(grid), dim3(512), LDS_BYTES, stream, p); }
#endif
#endif
}
```

```cpp
#include <hip/hip_runtime.h>
#include <cstdio>
#include <cstdint>

#ifndef DATAFLOW
#define DATAFLOW 0
#endif
#ifndef N_LAUNCHES
#define N_LAUNCHES 1
#endif

#define LAS __attribute__((address_space(3)))
#define GAS __attribute__((address_space(1)))
typedef unsigned short bf16;
typedef short bf16x8 __attribute__((ext_vector_type(8)));
typedef float f32x4 __attribute__((ext_vector_type(4)));
typedef unsigned u32x4 __attribute__((ext_vector_type(4)));
typedef unsigned u32x2 __attribute__((ext_vector_type(2)));

constexpr int DM = 4096, NBATCH = 4, SEQ = 2048, DEPTH = 4, DBATCH = 128, DSEQ = 8;
constexpr int MP = NBATCH * SEQ, MS = DBATCH * DSEQ, MR = MP + MS;
constexpr int PW = 2048, INC = 18432, NPAN = MR / 256, NPP = MP / 256;
constexpr float EPS = 1e-6f;
constexpr size_t O_Y = 0, O_SPP = (size_t)MR * DM, O_SPS = O_SPP + (size_t)DEPTH * NBATCH * 15 * PW, O_SGV = O_SPS + (size_t)DEPTH * DBATCH * 15 * PW,
                 O_END = O_SGV + (size_t)DEPTH * DBATCH * DSEQ * PW;

constexpr size_t MiB = 1u << 20;
constexpr size_t WS_CTL = 0, CTL_ZERO_BYTES = 1 * MiB;
constexpr size_t WS_WIN = 2 * MiB;
constexpr size_t WS_WBR = WS_WIN + (size_t)DEPTH * INC * DM * 2;
constexpr size_t WS_WO  = WS_WBR + (size_t)DEPTH * DM * DM * 2;
constexpr size_t WS_PWT = WS_WO + (size_t)DEPTH * DM * DM * 2;
constexpr size_t WS_WBLK = WS_PWT + (size_t)DEPTH * 4 * 512 * 512 * 2;
constexpr size_t WS_XF = WS_WBLK + (size_t)DEPTH * 8 * 2 * 65536 * 2;
constexpr size_t WS_XB = WS_XF + (size_t)MR * DM * 4;
constexpr size_t WS_A = WS_XB + (size_t)MR * DM * 2;
constexpr size_t WS_V = WS_A + (size_t)MR * PW * 2;
constexpr size_t WS_SGA = WS_V + (size_t)MR * PW * 2;
constexpr size_t WS_UG = WS_SGA + (size_t)MR * PW * 2;
constexpr size_t WS_RATIO = WS_UG + (size_t)MR * PW * 2;
constexpr size_t WS_SIGB = WS_RATIO + (size_t)MR * DM * 2;
constexpr size_t WS_POOLED = WS_SIGB + (size_t)MR * DM * 2;
constexpr size_t WS_VNT = WS_POOLED + (size_t)MR * PW * 2;
constexpr size_t WS_YCAT = WS_VNT + (size_t)MR * PW * 2;
constexpr size_t WS_MERGED = WS_YCAT + (size_t)MR * DM * 2;
constexpr size_t WS_HALO = WS_MERGED + (size_t)MR * DM * 2;
constexpr size_t WS_TMP = WS_HALO + (size_t)DEPTH * NPAN * 15 * PW * 2;
constexpr size_t WS_END = WS_TMP + (size_t)MR * DM * 4;
constexpr int CW_TMO = 0, CW_BAR = 4096, CW_SUMSQ = 16384  , CW_E1 = 65536  , CW_CNT = 81920  ;
static_assert((CW_CNT + DEPTH * NPAN * 8 * 16) * 4 <= (int)CTL_ZERO_BYTES, "ctl");
static_assert(CW_SUMSQ + 5 * MR <= CW_E1 && CW_E1 + DEPTH * NPAN * 72 <= CW_CNT, "ctl map");

constexpr int RING_BYTES = 131072, MISC_OFF = RING_BYTES + 64, LDS_BYTES = 147456;
constexpr int HTB = 128 * 64 * 2;

#define LDS_WAIT() asm volatile("s_waitcnt lgkmcnt(0)" ::: "memory")
#define VM_WAIT() asm volatile("s_waitcnt vmcnt(0)" ::: "memory")
typedef float f32x2_t __attribute__((ext_vector_type(2)));
typedef __bf16 bf16x2_t __attribute__((ext_vector_type(2)));
__device__ __forceinline__ unsigned cvt_pk_bf16(float lo, float hi) { const f32x2_t v = {lo, hi}; return __builtin_bit_cast(unsigned, __builtin_convertvector(v, bf16x2_t)); }
__device__ __forceinline__ float bf_lo(unsigned w) { return __uint_as_float(w << 16); }
__device__ __forceinline__ float bf_hi(unsigned w) { return __uint_as_float(w & 0xffff0000u); }
__device__ __forceinline__ float fast_exp(float x) { return __builtin_amdgcn_exp2f(x * 1.44269504f); }
__device__ __forceinline__ float fast_rcp(float x) { return __builtin_amdgcn_rcpf(x); }
__device__ __forceinline__ float silu_f(float x) { return x * fast_rcp(1.0f + fast_exp(-x)); }
__device__ __forceinline__ float wave_sum(float v) {
#pragma unroll
    for (int o = 1; o < 64; o <<= 1) v += __shfl_xor(v, o);
    return v;
}
__host__ __device__ __forceinline__ int lds_byte(int r, int c) { const int st = (r >> 4) * 2 + (c >> 5), rr = r & 15, cc = c & 31, ob = rr * 64 + cc * 2; return st * 1024 + (ob ^ (((ob >> 9) & 1) << 5)); }
__host__ __device__ __forceinline__ int invperm32(int i) { return 16 * ((i >> 2) & 1) + 4 * (i >> 3) + (i & 3); }

#define XB_TMO      128
#define XB_XCNT(j)  (256  + 64 * (j))
#define XB_XSUB(j)  (1280 + 64 * (j))
#define XB_XGEN(j)  (2304 + 64 * (j))
#define XB_TOP      3328
#define XB_TOPGEN   3392
#define XCD_BAR_WORDS 3456
#define XB_SPIN_CAP (1u << 18)
__device__ __forceinline__ unsigned xb_ld(unsigned* p)              { return __hip_atomic_load(p, __ATOMIC_RELAXED, __HIP_MEMORY_SCOPE_AGENT); }
__device__ __forceinline__ unsigned xb_add(unsigned* p, unsigned v) { return __hip_atomic_fetch_add(p, v, __ATOMIC_RELAXED, __HIP_MEMORY_SCOPE_AGENT); }
__device__ __forceinline__ unsigned xb_xcc_id() { return (unsigned)__builtin_amdgcn_s_getreg((3 << 11) | 20) & 0xFu; }
#define XB_SPIN(cond, bar) do { unsigned _sp = 0; while (cond) { __builtin_amdgcn_s_sleep(1); \
    if ((++_sp & 255u) == 0u) { if (xb_ld(&(bar)[XB_TMO])) break; if (_sp > XB_SPIN_CAP) { atomicAdd(&(bar)[XB_TMO], 1u); break; } } } } while (0)
struct XcdBarrier { unsigned* bar; unsigned x; volatile LAS unsigned* st; };
__device__ __forceinline__ XcdBarrier xcd_barrier_post(unsigned* bar, volatile LAS unsigned* st) {
    XcdBarrier b; b.bar = bar; b.x = xb_xcc_id(); b.st = st;
    if (threadIdx.x == 0) (void)xb_add(&bar[XB_XCNT(b.x)], 1u);
    return b;
}
__device__ __forceinline__ void xcd_barrier_complete(unsigned* bar, unsigned x, unsigned& nloc, unsigned& nx) {
    const unsigned G = gridDim.x * gridDim.y * gridDim.z;
    unsigned sum, cnt, mine, sp = 0u;
    for (;;) {
        sum = 0u; cnt = 0u; mine = 0u;
#pragma unroll
        for (unsigned j = 0; j < 16; ++j) { const unsigned c = xb_ld(&bar[XB_XCNT(j)]); sum += c; cnt += (c > 0u) ? 1u : 0u; mine = (j == x) ? c : mine; }
        if (sum == G) break;
        __builtin_amdgcn_s_sleep(1);
        if ((++sp & 255u) == 0u) { if (xb_ld(&bar[XB_TMO])) break; if (sp > XB_SPIN_CAP) { atomicAdd(&bar[XB_TMO], 1u); break; } }
    }
    nloc = mine > 0u ? mine : 1u; nx = cnt > 0u ? cnt : 1u;
}
__device__ __forceinline__ void xcd_barrier(const XcdBarrier& b) {
    asm volatile("s_waitcnt vmcnt(0)" ::: "memory");
    __syncthreads();
    if (threadIdx.x == 0) {
        unsigned* bar = b.bar; unsigned bx = b.x;
        asm volatile("" : "+s"(bar), "+s"(bx));
        __builtin_amdgcn_s_waitcnt(0);
        unsigned nloc = b.st[0], nx = b.st[1];
        if (nloc == 0u) { xcd_barrier_complete(bar, bx, nloc, nx); b.st[0] = nloc; b.st[1] = nx; }
        const unsigned old = xb_add(&bar[XB_XSUB(bx)], 1u);
        const unsigned gen = old / nloc;
        if (old + 1u == (gen + 1u) * nloc) {
            __builtin_amdgcn_fence(__ATOMIC_RELEASE, "agent");
            asm volatile("s_waitcnt vmcnt(0)" ::: "memory");
            const unsigned og = xb_add(&bar[XB_TOP], 1u);
            const unsigned tg = og / nx;
            if (og + 1u == (tg + 1u) * nx) xb_add(&bar[XB_TOPGEN], 1u);
            else XB_SPIN(xb_ld(&bar[XB_TOPGEN]) == tg, bar);
            __builtin_amdgcn_fence(__ATOMIC_ACQUIRE, "agent");
            xb_add(&bar[XB_XGEN(bx)], 1u);
            asm volatile("s_waitcnt vmcnt(0)" ::: "memory");
        } else {
            XB_SPIN(xb_ld(&bar[XB_XGEN(bx)]) == gen, bar);
            __builtin_amdgcn_fence(__ATOMIC_ACQUIRE, "agent");
            asm volatile("s_waitcnt vmcnt(0)" ::: "memory");
        }
    }
    __syncthreads();
}

struct Params { const float* in[14]; float* out; unsigned char* ws; int ph_lo, ph_hi; };
enum { I_XP = 0, I_XS, I_STATE, I_NORMG, I_WIN, I_POOLW, I_PSCALE, I_SGUG, I_SGUW, I_SGUB, I_WBA, I_WBB, I_WOUT, I_FING };

struct Ctx {
    LAS unsigned char* lds;
    int tid, lane, wid;
    int G, W, xcd, rank;
};

constexpr int Q_P1 = 0, Q_PV = 324, Q_SM = 360, Q_BR = 432, Q_OUT = 504, Q_FIN = 576, Q_END = 612;
enum { K_P1 = 0, K_PV, K_PG, K_SG, K_BR, K_OUT, K_FIN };
struct Ent { int kind, p, j; };
__device__ __forceinline__ Ent decode_ent(int q, int x) {
    Ent e;
    if (q < Q_PV) { e.kind = K_P1; if (q < 288) { e.j = q >> 2; e.p = 4 * x + (q & 3); } else { const int i = q - 288; e.p = NPP + (x & 3); e.j = 2 * i + (x >> 2); } }
    else if (q < Q_SM || q >= Q_FIN) { const int t = (q >= Q_FIN) ? q - Q_FIN : q - Q_PV; e.kind = (q >= Q_FIN) ? K_FIN : K_PV;
        if (t < 32) { e.p = 4 * x + (t >> 3); e.j = t & 7; } else { const int id = 4 * x + (t - 32); e.p = NPP + (id >> 3); e.j = id & 7; } }
    else if (q < Q_BR) { const int t = q - Q_SM; int k; if (t < 64) { e.p = 4 * x + (t >> 4); k = t & 15; } else { const int id = 8 * x + (t - 64); e.p = NPP + (id >> 4); k = id & 15; }
        e.kind = k < 8 ? K_PG : K_SG; e.j = k & 7; }
    else { const int t = (q < Q_OUT) ? q - Q_BR : q - Q_OUT; e.kind = (q < Q_OUT) ? K_BR : K_OUT;
        if (t < 64) { e.j = t >> 2; e.p = 4 * x + (t & 3); } else { const int id = 8 * x + (t - 64); e.p = NPP + (id >> 4); e.j = id & 15; } }
    return e;
}

enum { T_P1A = 0, T_P1V, T_P1GA, T_P1UG, T_P1SEL, T_PG, T_SG, T_BRA, T_BRB, T_OUT };
struct GOps { unsigned offA, offB, lda, ldb; int nt; };
struct GUnit { int type, l, p, j; };
__device__ __forceinline__ GUnit unit_of(int l, const Ent& e, int sub) {
    GUnit u; u.l = l; u.p = e.p; u.j = e.j;
    if (e.kind == K_P1) u.type = e.j < 8 ? T_P1A : e.j < 16 ? T_P1V : e.j < 24 ? T_P1GA : e.j < 40 ? T_P1UG : T_P1SEL;
    else if (e.kind == K_PG) u.type = T_PG; else if (e.kind == K_SG) u.type = T_SG; else if (e.kind == K_BR) u.type = sub ? T_BRB : T_BRA; else u.type = T_OUT;
    return u;
}
__device__ __forceinline__ GOps ops_of(int l, const Ent& e, int sub) {
    GOps u;
    if (e.kind == K_P1) {
        u.offA = (unsigned)(WS_XB + (size_t)e.p * 256 * DM * 2); u.lda = DM * 2;
        u.offB = (unsigned)(WS_WIN + ((size_t)l * INC + (size_t)e.j * 256) * DM * 2); u.ldb = DM * 2; u.nt = DM / 64;
    } else if (e.kind == K_PG) {
        const int g = e.j >> 1;
        u.offA = (unsigned)(WS_POOLED + ((size_t)e.p * 256 * PW + g * 512) * 2); u.lda = PW * 2;
        u.offB = (unsigned)(WS_PWT + ((size_t)((l * 4 + g) * 512 + (e.j & 1) * 256) * 512) * 2); u.ldb = 512 * 2; u.nt = 8;
    } else if (e.kind == K_SG) {
        u.offA = (unsigned)(WS_WBLK + (size_t)(((l * 8 + e.j) * 2 + (e.p >= NPP ? 1 : 0)) * 65536) * 2); u.lda = 256 * 2;
        u.offB = (unsigned)(WS_VNT + ((size_t)(e.j * 256) * MR + (size_t)e.p * 256) * 2); u.ldb = MR * 2; u.nt = 4;
    } else if (e.kind == K_BR) {
        u.offA = (unsigned)(WS_YCAT + ((size_t)e.p * 256 * DM + sub * 2048) * 2); u.lda = DM * 2;
        u.offB = (unsigned)(WS_WBR + (((size_t)l * DM + (size_t)e.j * 256) * DM + sub * 2048) * 2); u.ldb = DM * 2; u.nt = 32;
    } else {
        u.offA = (unsigned)(WS_MERGED + (size_t)e.p * 256 * DM * 2); u.lda = DM * 2;
        u.offB = (unsigned)(WS_WO + ((size_t)l * DM + (size_t)e.j * 256) * DM * 2); u.ldb = DM * 2; u.nt = 64;
    }
    return u;
}
static_assert(WS_END < (1ull << 32), "GEMM operand offsets are 32-bit");

typedef f32x4 Acc[2][2][4][2];
__device__ __forceinline__ u32x4 pack8(const f32x4 a, const f32x4 b) { u32x4 w; w.x = cvt_pk_bf16(a[0], a[1]); w.y = cvt_pk_bf16(a[2], a[3]); w.z = cvt_pk_bf16(b[0], b[1]); w.w = cvt_pk_bf16(b[2], b[3]); return w; }
__device__ __forceinline__ void unpack8(const u32x4 w, f32x4& a, f32x4& b) { a = (f32x4){bf_lo(w.x), bf_hi(w.x), bf_lo(w.y), bf_hi(w.y)}; b = (f32x4){bf_lo(w.z), bf_hi(w.z), bf_lo(w.w), bf_hi(w.w)}; }
#define ST16(ptr, val) (*(u32x4*)(ptr) = (val))
#define ST16F(ptr, val) (*(f32x4*)(ptr) = (val))
#define LD16(ptr) (*(const u32x4*)(ptr))
#define LD16F(ptr) (*(const f32x4*)(ptr))
#define EPI_ROWS(ai, m) _Pragma("unroll") for (int ai = 0; ai < 2; ++ai) _Pragma("unroll") for (int m = 0; m < 4; ++m)
#define ROWOFF(ai, m) ((ai) * 128 + (m) * 16)
#define EPI_FENCE() asm volatile("" ::: "memory")

__device__ __forceinline__ void epi_p1(const Params& P, const Acc& acc, const GUnit& u, int wr, int rl0, int cb) {
    unsigned char* ws = P.ws;
    const char* ssq = (const char*)((const float*)(ws + WS_CTL) + CW_SUMSQ + (size_t)u.l * MR + (size_t)u.p * 256);
    const unsigned vo_s = (unsigned)rl0 * 4u;
    float rs[2][4];
    EPI_ROWS(ai, m) rs[ai][m] = 1.0f / sqrtf(*(const float*)(ssq + ROWOFF(ai, m) * 4 + vo_s) * (1.0f / DM) + EPS);
    const unsigned vo_pw = (unsigned)(rl0 * PW + cb) * 2u, vo_dm = (unsigned)(rl0 * DM + cb) * 2u;
    if (u.type == T_P1A) {
        char* dst = (char*)((bf16*)(ws + WS_A) + (size_t)u.p * 256 * PW + u.j * 256);
        const int fr = rl0 & 15;
        EPI_ROWS(ai, m) {
            const float r = rs[ai][m];
#pragma unroll
            for (int bj = 0; bj < 2; ++bj) {
                const f32x4 v0 = acc[ai][bj][m][0] * r, v1 = acc[ai][bj][m][1] * r;
                const u32x4 w = pack8(v0, v1);
                ST16(dst + (size_t)ROWOFF(ai, m) * PW * 2 + bj * 256 + vo_pw, w);
                if (ai == 1 && m == 3) {
                    if (wr == 1 && fr >= 1) {
                        const unsigned vo_h = (unsigned)((fr - 1) * PW + cb) * 2u;
                        ST16((char*)((bf16*)(ws + WS_HALO) + (size_t)(u.l * NPAN + u.p) * 15 * PW + u.j * 256) + bj * 256 + vo_h, w);
                        if (u.p < NPP && (u.p & 7) == 7) { char* o = (char*)(P.out + O_SPP + (size_t)(u.l * NBATCH + (u.p >> 3)) * 15 * PW + u.j * 256) + bj * 512 + 2 * vo_h; ST16F(o, v0); ST16F(o + 16, v1); }
                    }
                }
                if (u.p >= NPP) {
                    const unsigned vo_o = (unsigned)(((rl0 >> 3) * 15 + (rl0 & 7)) * PW + cb) * 4u;
                    char* o = (char*)(P.out + O_SPS + ((size_t)(u.l * DBATCH + (u.p - NPP) * 32 + ROWOFF(ai, m) / 8) * 15 + 7) * PW + u.j * 256) + bj * 512 + vo_o; ST16F(o, v0); ST16F(o + 16, v1);
                }
            }
            EPI_FENCE();
        }
    } else if (u.type == T_P1V || u.type == T_P1GA) {
        char* dst = (char*)((bf16*)(ws + (u.type == T_P1V ? WS_V : WS_SGA)) + (size_t)u.p * 256 * PW + (u.type == T_P1V ? u.j - 8 : u.j - 16) * 256);
        const bool act = u.type == T_P1GA;
        EPI_ROWS(ai, m) {
            const float r = rs[ai][m];
#pragma unroll
            for (int bj = 0; bj < 2; ++bj) {
                f32x4 v0 = acc[ai][bj][m][0] * r, v1 = acc[ai][bj][m][1] * r;
                if (act) {
#pragma unroll
                    for (int k = 0; k < 4; ++k) { v0[k] = silu_f(v0[k]); v1[k] = silu_f(v1[k]); }
                }
                ST16(dst + (size_t)ROWOFF(ai, m) * PW * 2 + bj * 256 + vo_pw, pack8(v0, v1));
            }
            EPI_FENCE();
        }
    } else if (u.type == T_P1UG) {
        char* dst = (char*)((bf16*)(ws + WS_UG) + (size_t)u.p * 256 * PW + (u.j - 24) * 128);
        EPI_ROWS(ai, m) {
            const float r = rs[ai][m];
            f32x4 o0, o1;
#pragma unroll
            for (int k = 0; k < 4; ++k) { o0[k] = acc[ai][0][m][0][k] * r * silu_f(acc[ai][1][m][0][k] * r); o1[k] = acc[ai][0][m][1][k] * r * silu_f(acc[ai][1][m][1][k] * r); }
            ST16(dst + (size_t)ROWOFF(ai, m) * PW * 2 + vo_pw, pack8(o0, o1));
            EPI_FENCE();
        }
    } else {
        char* dr = (char*)((bf16*)(ws + WS_RATIO) + (size_t)u.p * 256 * DM + (u.j - 40) * 128);
        char* ds = (char*)((bf16*)(ws + WS_SIGB) + (size_t)u.p * 256 * DM + (u.j - 40) * 128);
        EPI_ROWS(ai, m) {
            const float r = rs[ai][m];
            f32x4 q0, q1, s0, s1;
#pragma unroll
            for (int k = 0; k < 4; ++k) {
                q0[k] = fast_rcp(1.0f + fast_exp(-acc[ai][0][m][0][k] * r)); s0[k] = fast_rcp(1.0f + fast_exp(-acc[ai][1][m][0][k] * r));
                q1[k] = fast_rcp(1.0f + fast_exp(-acc[ai][0][m][1][k] * r)); s1[k] = fast_rcp(1.0f + fast_exp(-acc[ai][1][m][1][k] * r));
            }
            ST16(dr + (size_t)ROWOFF(ai, m) * DM * 2 + vo_dm, pack8(q0, q1)); ST16(ds + (size_t)ROWOFF(ai, m) * DM * 2 + vo_dm, pack8(s0, s1));
            EPI_FENCE();
        }
    }
}

#define EPI_BATCH(ai, mh) _Pragma("unroll") for (int ai = 0; ai < 2; ++ai) _Pragma("unroll") for (int mh = 0; mh < 2; ++mh)
#define EPI_IN(mi, bj) _Pragma("unroll") for (int mi = 0; mi < 2; ++mi) _Pragma("unroll") for (int bj = 0; bj < 2; ++bj)
__device__ __forceinline__ void epi_pg(const Params& P, const Acc& acc, const GUnit& u, int rl0, int cb) {
    unsigned char* ws = P.ws;
    const unsigned vo_pw = (unsigned)(rl0 * PW + cb) * 2u, vo_dm = (unsigned)(rl0 * DM + cb) * 2u, vo_c = (unsigned)cb * 4u;
    const char* sc = (const char*)(P.in[I_PSCALE] + (size_t)u.l * PW + u.j * 256);
    f32x4 s[2][2];
#pragma unroll
    for (int bj = 0; bj < 2; ++bj) { s[bj][0] = LD16F(sc + bj * 512 + vo_c); s[bj][1] = LD16F(sc + bj * 512 + 16 + vo_c); }
    const char* ga = (const char*)((const bf16*)(ws + WS_SGA) + (size_t)u.p * 256 * PW + u.j * 256);
    char* dst = (char*)((bf16*)(ws + WS_YCAT) + (size_t)u.p * 256 * DM + u.j * 256);
    EPI_BATCH(ai, mh) {
        u32x4 g[2][2];
        EPI_IN(mi, bj) g[mi][bj] = LD16(ga + (size_t)ROWOFF(ai, 2 * mh + mi) * PW * 2 + bj * 256 + vo_pw);
        EPI_IN(mi, bj) { const int m = 2 * mh + mi; f32x4 g0, g1; unpack8(g[mi][bj], g0, g1);
            ST16(dst + (size_t)ROWOFF(ai, m) * DM * 2 + bj * 256 + vo_dm, pack8(acc[ai][bj][m][0] * s[bj][0] * g0, acc[ai][bj][m][1] * s[bj][1] * g1)); }
        EPI_FENCE();
    }
}
__device__ __forceinline__ void epi_sg(const Params& P, const Acc& acc, const GUnit& u, int rl0, int cb) {
    unsigned char* ws = P.ws;
    const unsigned vo_pw = (unsigned)(rl0 * PW + cb) * 2u, vo_dm = (unsigned)(rl0 * DM + cb) * 2u;
    const char* bs = (const char*)(P.in[I_SGUB] + (size_t)(u.l * 8 + u.j) * 128);
    const int tmask = u.p < NPP ? 127 : 7;
    const char* ug = (const char*)((const bf16*)(ws + WS_UG) + (size_t)u.p * 256 * PW + u.j * 256);
    char* dst = (char*)((bf16*)(ws + WS_YCAT) + (size_t)u.p * 256 * DM + 2048 + u.j * 256);
    EPI_BATCH(ai, mh) {
        u32x4 g[2][2]; float b[2];
#pragma unroll
        for (int mi = 0; mi < 2; ++mi) b[mi] = *(const float*)(bs + (unsigned)(((rl0 + ROWOFF(ai, 2 * mh + mi)) & tmask) * 4));
        EPI_IN(mi, bj) g[mi][bj] = LD16(ug + (size_t)ROWOFF(ai, 2 * mh + mi) * PW * 2 + bj * 256 + vo_pw);
        EPI_IN(mi, bj) { const int m = 2 * mh + mi; f32x4 g0, g1; unpack8(g[mi][bj], g0, g1);
            ST16(dst + (size_t)ROWOFF(ai, m) * DM * 2 + bj * 256 + vo_dm, pack8((acc[ai][bj][m][0] + b[mi]) * g0, (acc[ai][bj][m][1] + b[mi]) * g1)); }
        EPI_FENCE();
    }
}
__device__ __forceinline__ void epi_br(const Params& P, const Acc& acc, const GUnit& u, int rl0, int cb) {
    unsigned char* ws = P.ws;
    const unsigned vo_dm = (unsigned)(rl0 * DM + cb) * 2u, vo_f = 2u * vo_dm;
    const char* src = (const char*)((const bf16*)(ws + (u.type == T_BRA ? WS_RATIO : WS_SIGB)) + (size_t)u.p * 256 * DM + u.j * 256);
    char* tmp = (char*)((float*)(ws + WS_TMP) + (size_t)u.p * 256 * DM + u.j * 256);
    char* dst = (char*)((bf16*)(ws + WS_MERGED) + (size_t)u.p * 256 * DM + u.j * 256);
    if (u.type == T_BRA) {
        EPI_BATCH(ai, mh) {
            u32x4 g[2][2];
            EPI_IN(mi, bj) g[mi][bj] = LD16(src + (size_t)ROWOFF(ai, 2 * mh + mi) * DM * 2 + bj * 256 + vo_dm);
            EPI_IN(mi, bj) { const int m = 2 * mh + mi; f32x4 g0, g1; unpack8(g[mi][bj], g0, g1);
                ST16F(tmp + (size_t)ROWOFF(ai, m) * DM * 4 + bj * 512 + vo_f, acc[ai][bj][m][0] * g0); ST16F(tmp + (size_t)ROWOFF(ai, m) * DM * 4 + bj * 512 + 16 + vo_f, acc[ai][bj][m][1] * g1); }
            EPI_FENCE();
        }
    } else {
        EPI_BATCH(ai, mh) {
            u32x4 g[2][2]; f32x4 t[2][2][2];
            EPI_IN(mi, bj) { const int m = 2 * mh + mi; g[mi][bj] = LD16(src + (size_t)ROWOFF(ai, m) * DM * 2 + bj * 256 + vo_dm);
                t[mi][bj][0] = LD16F(tmp + (size_t)ROWOFF(ai, m) * DM * 4 + bj * 512 + vo_f); t[mi][bj][1] = LD16F(tmp + (size_t)ROWOFF(ai, m) * DM * 4 + bj * 512 + 16 + vo_f); }
            EPI_IN(mi, bj) { const int m = 2 * mh + mi; f32x4 g0, g1; unpack8(g[mi][bj], g0, g1);
                ST16(dst + (size_t)ROWOFF(ai, m) * DM * 2 + bj * 256 + vo_dm, pack8(t[mi][bj][0] + acc[ai][bj][m][0] * g0, t[mi][bj][1] + acc[ai][bj][m][1] * g1)); }
            EPI_FENCE();
        }
    }
}
__device__ __forceinline__ void epi_out(const Params& P, const Acc& acc, const GUnit& u, int rl0, int cb) {
    unsigned char* ws = P.ws;
    const unsigned vo_b = (unsigned)(rl0 * DM + cb) * 2u, vo_f = 2u * vo_b, vo_s = (unsigned)rl0 * 4u;
    const char* xin = (const char*)((u.l == 0) ? (u.p < NPP ? P.in[I_XP] + (size_t)u.p * 256 * DM : P.in[I_XS] + (size_t)(u.p - NPP) * 256 * DM) : (const float*)(ws + WS_XF) + (size_t)u.p * 256 * DM) + (size_t)u.j * 1024;
    char* xf = (char*)((float*)(ws + WS_XF) + (size_t)u.p * 256 * DM + u.j * 256);
    char* xb = (char*)((bf16*)(ws + WS_XB) + (size_t)u.p * 256 * DM + u.j * 256);
    char* ssq = (char*)((float*)(ws + WS_CTL) + CW_SUMSQ + (size_t)(u.l + 1) * MR + (size_t)u.p * 256);
    const bool lead = ((cb >> 3) & 3) == 0;
    EPI_BATCH(ai, mh) {
        f32x4 t[2][2][2];
        EPI_IN(mi, bj) { const int m = 2 * mh + mi; t[mi][bj][0] = LD16F(xin + (size_t)ROWOFF(ai, m) * DM * 4 + bj * 512 + vo_f); t[mi][bj][1] = LD16F(xin + (size_t)ROWOFF(ai, m) * DM * 4 + bj * 512 + 16 + vo_f); }
#pragma unroll
        for (int mi = 0; mi < 2; ++mi) { const int m = 2 * mh + mi; float ss = 0.f;
#pragma unroll
            for (int bj = 0; bj < 2; ++bj) {
                const f32x4 x0 = t[mi][bj][0] + acc[ai][bj][m][0], x1 = t[mi][bj][1] + acc[ai][bj][m][1];
                ST16F(xf + (size_t)ROWOFF(ai, m) * DM * 4 + bj * 512 + vo_f, x0); ST16F(xf + (size_t)ROWOFF(ai, m) * DM * 4 + bj * 512 + 16 + vo_f, x1);
                ST16(xb + (size_t)ROWOFF(ai, m) * DM * 2 + bj * 256 + vo_b, pack8(x0, x1));
                ss += (x0[0] * x0[0] + x0[1] * x0[1]) + (x0[2] * x0[2] + x0[3] * x0[3]) + (x1[0] * x1[0] + x1[1] * x1[1]) + (x1[2] * x1[2] + x1[3] * x1[3]);
            }
            ss += __shfl_xor(ss, 16); ss += __shfl_xor(ss, 32);
            if (lead) atomicAdd((float*)(ssq + ROWOFF(ai, m) * 4 + vo_s), ss);
        }
        EPI_FENCE();
    }
}

#define G_SA(b, h) (((b) * 2 + (h)) * HTB)
#define G_SB(b, h) ((4 + (b) * 2 + (h)) * HTB)
#define G_STAGE(bufoff, off32, r64, voff) do { \
        __builtin_amdgcn_global_load_lds((const unsigned*)(wsb + (unsigned)((off32) + (voff))), (LAS unsigned*)(lds + (bufoff) + ldsw), 16, 0, 0); \
        __builtin_amdgcn_global_load_lds((const unsigned*)(wsb + (unsigned)((off32) + (r64) + (voff))), (LAS unsigned*)(lds + (bufoff) + ldsw + 8192), 16, 0, 0); } while (0)
#define G_LDA(dst, b, h) do { _Pragma("unroll") for (int m = 0; m < 4; ++m) _Pragma("unroll") for (int k = 0; k < 2; ++k) dst[m][k] = *(const LAS bf16x8*)(lds + G_SA(b, h) + aoff + m * 2048 + k * 1024); } while (0)
#define G_LDB(dst, b, h) do { _Pragma("unroll") for (int n = 0; n < 2; ++n) _Pragma("unroll") for (int k = 0; k < 2; ++k) dst[n][k] = *(const LAS bf16x8*)(lds + G_SB(b, h) + boff + n * 2048 + k * 1024); } while (0)
#define G_MMA(ai, bj, At, Bt) do { __builtin_amdgcn_s_setprio(1); _Pragma("unroll") for (int m = 0; m < 4; ++m) _Pragma("unroll") for (int n = 0; n < 2; ++n) _Pragma("unroll") for (int k = 0; k < 2; ++k) \
        acc[ai][bj][m][n] = __builtin_amdgcn_mfma_f32_16x16x32_bf16(Bt[n][k], At[m][k], acc[ai][bj][m][n], 0, 0, 0); __builtin_amdgcn_s_setprio(0); } while (0)
#define G_WAIT_V(n) asm volatile("s_waitcnt vmcnt(" #n ")" ::: "memory")
#define G_WAIT_L(n) asm volatile("s_waitcnt lgkmcnt(" #n ")" ::: "memory")
#define G_BAR __builtin_amdgcn_s_barrier()
#define G_SCHED __builtin_amdgcn_sched_barrier(0)

__device__ __forceinline__ void gemm_stream(const Params& P, const Ctx& C, int l, int q, int qend) {
    LAS unsigned char* lds = C.lds;
    const char* wsb = (const char*)P.ws;
    int lane = C.lane; asm volatile("" : "+v"(lane));
    const int wid = C.wid, wr = wid >> 2, wc = wid & 3, fr = lane & 15, fq = lane >> 4;
#define G_SRC() int _tz = lane; asm volatile("" : "+v"(_tz)); const int _sb = _tz * 16, _swz = _sb ^ (((_sb >> 9) & 1) << 5); \
        const unsigned sR = (unsigned)((wid >> 1) * 16 + _swz / 64), sC2 = (unsigned)(((wid & 1) * 32 + (_swz % 64) / 2) * 2)
    const unsigned ldsw = (unsigned)wid * 1024u;
    const int aoff = lds_byte(wr * 64 + fr, fq * 8), boff = lds_byte(wc * 32 + fr, fq * 8);
    int sub = 0;
    GOps cur;
    { const Ent e = decode_ent(q, C.xcd); cur = ops_of(l, e, 0); }
    Acc acc;
#pragma unroll
    for (int a = 0; a < 2; ++a)
#pragma unroll
        for (int b = 0; b < 2; ++b)
#pragma unroll
            for (int m = 0; m < 4; ++m)
#pragma unroll
                for (int n = 0; n < 2; ++n) acc[a][b][m][n] = (f32x4){0.f, 0.f, 0.f, 0.f};
    bf16x8 At[4][2], B0[2][2], B1[2][2];
    unsigned cA = cur.offA, cB = cur.offB, rA = cur.lda * 64u, rB = cur.ldb * 64u;
    unsigned voffA, voffB;
    { G_SRC(); voffA = sR * cur.lda + sC2; voffB = sR * cur.ldb + sC2; }
    int nt = cur.nt;
    G_STAGE(G_SB(0, 0), cB, rB, voffB); G_STAGE(G_SB(0, 1), cB + 2 * rB, rB, voffB); G_STAGE(G_SA(0, 0), cA, rA, voffA); G_STAGE(G_SA(0, 1), cA + 2 * rA, rA, voffA);
    if (wr == 1) G_BAR;
    G_WAIT_V(2); G_BAR;
    G_STAGE(G_SB(1, 0), cB + 128, rB, voffB); G_STAGE(G_SA(1, 0), cA + 128, rA, voffA); G_STAGE(G_SB(1, 1), cB + 2 * rB + 128, rB, voffB);
    G_WAIT_V(6); G_BAR;
    for (;;) {
        bool has_next = true;
        unsigned a2 = cA + 256, b2 = cB + 256, rA2 = rA, rB2 = rB, vA2 = voffA, vB2 = voffB; int nnt = nt;
        for (int t = 0; t < nt; t += 2) {
            if (t == nt - 2) {
                int qn = q, subn = 0; Ent en = decode_ent(q, C.xcd);
                if (en.kind == K_BR && sub == 0) subn = 1; else { qn = q + C.W; has_next = qn < qend; if (has_next) en = decode_ent(qn, C.xcd); }
                if (has_next) { G_SRC(); const GOps nx = ops_of(l, en, subn); a2 = nx.offA; b2 = nx.offB; rA2 = nx.lda * 64u; rB2 = nx.ldb * 64u; vA2 = sR * nx.lda + sC2; vB2 = sR * nx.ldb + sC2; nnt = nx.nt; }
                else { a2 = cA; b2 = cB; }
            }
            const unsigned a1 = cA + (unsigned)(t + 1) * 128u;
            G_LDB(B0, 0, 0); G_LDB(B1, 0, 1); G_SCHED; G_LDA(At, 0, 0); G_STAGE(G_SA(1, 1), a1 + 2 * rA, rA, voffA);
            G_WAIT_V(8); G_WAIT_L(0); G_BAR; G_MMA(0, 0, At, B0); G_MMA(0, 1, At, B1); G_BAR; G_SCHED;
            G_LDA(At, 0, 1); G_STAGE(G_SB(0, 0), b2, rB2, vB2); G_STAGE(G_SB(0, 1), b2 + 2 * rB2, rB2, vB2); G_STAGE(G_SA(0, 0), a2, rA2, vA2);
            G_WAIT_V(8); G_WAIT_L(0); G_BAR; G_MMA(1, 0, At, B0); G_MMA(1, 1, At, B1); G_BAR; G_SCHED;
            G_LDB(B0, 1, 0); G_LDB(B1, 1, 1); G_SCHED; G_LDA(At, 1, 0); G_STAGE(G_SA(0, 1), a2 + 2 * rA2, rA2, vA2);
            G_WAIT_V(8); G_WAIT_L(0); G_BAR; G_MMA(0, 0, At, B0); G_MMA(0, 1, At, B1); G_BAR; G_SCHED;
            G_LDA(At, 1, 1); G_STAGE(G_SB(1, 0), b2 + 128, rB2, vB2); G_STAGE(G_SB(1, 1), b2 + 128 + 2 * rB2, rB2, vB2); G_STAGE(G_SA(1, 0), a2 + 128, rA2, vA2);
            G_WAIT_V(8); G_WAIT_L(0); G_BAR; G_MMA(1, 0, At, B0); G_MMA(1, 1, At, B1); G_BAR; G_SCHED;
            a2 += 256; b2 += 256;
        }
        if (wr == 0) G_BAR;
        const Ent ec = decode_ent(q, C.xcd);
        const GUnit u = unit_of(l, ec, sub);
        int e_rl0 = wr * 64 + fr, e_cb = wc * 32 + fq * 8;
        asm volatile("" : "+v"(e_rl0), "+v"(e_cb));
        switch (u.type) {
            case T_PG: epi_pg(P, acc, u, e_rl0, e_cb); break;
            case T_SG: epi_sg(P, acc, u, e_rl0, e_cb); break;
            case T_BRA: case T_BRB: epi_br(P, acc, u, e_rl0, e_cb); break;
            case T_OUT: epi_out(P, acc, u, e_rl0, e_cb); break;
            default: epi_p1(P, acc, u, wr, e_rl0, e_cb); break;
        }
        if (!has_next) break;
#pragma unroll
        for (int a = 0; a < 2; ++a)
#pragma unroll
            for (int b = 0; b < 2; ++b)
#pragma unroll
                for (int m = 0; m < 4; ++m)
#pragma unroll
                    for (int n = 0; n < 2; ++n) acc[a][b][m][n] = (f32x4){0.f, 0.f, 0.f, 0.f};
        if (ec.kind == K_BR && sub == 0) sub = 1; else { q += C.W; sub = 0; }
        cA = a2 - 256; cB = b2 - 256; rA = rA2; rB = rB2; voffA = vA2; voffB = vB2; nt = nnt;
        if (wr == 1) G_BAR;
    }
    G_WAIT_V(0);
    G_BAR;
}

__device__ __forceinline__ f32x4 ld_bf4(const bf16* p) { const u32x2 w = *(const u32x2*)p; return (f32x4){bf_lo(w.x), bf_hi(w.x), bf_lo(w.y), bf_hi(w.y)}; }
__device__ __forceinline__ void pv_unit(const Params& P, const Ctx& C, int l, int p, int blk) {
    unsigned char* ws = P.ws;
    int tid = C.tid; asm volatile("" : "+v"(tid));
    const int lane = tid & 63, wid = C.wid;
    const int row0 = 256 * p + 32 * blk;
    const bf16* abuf = (const bf16*)(ws + WS_A);
    bf16* pooled = (bf16*)(ws + WS_POOLED);
    {
        const int c0 = 4 * tid, w = 2 << (tid >> 7);
        const float rw = 1.0f / (float)w;
        if (p < NPP) {
            const int sp0 = row0 & (SEQ - 1);
            const bf16* halo = (const bf16*)(ws + WS_HALO) + ((size_t)(l * NPAN + p - 1) * 15) * PW;
            f32x4 S = (f32x4){0.f, 0.f, 0.f, 0.f};
            for (int k = 1; k < w; ++k) {
                if (sp0 - k >= 0) S += (blk == 0) ? ld_bf4(halo + (size_t)(15 - k) * PW + c0) : ld_bf4(abuf + (size_t)(row0 - k) * PW + c0);
            }
#pragma unroll 4
            for (int t = 0; t < 32; ++t) {
                const f32x4 x = ld_bf4(abuf + (size_t)(row0 + t) * PW + c0);
                S += x;
                const int pos = sp0 + t; const float rc = (pos + 1 < w) ? 1.0f / (float)(pos + 1) : rw;
                const f32x4 o = S * rc - x;
                u32x2 pk; pk.x = cvt_pk_bf16(o[0], o[1]); pk.y = cvt_pk_bf16(o[2], o[3]);
                *(u32x2*)(pooled + (size_t)(row0 + t) * PW + c0) = pk;
                const int tt = t - w + 1;
                if (sp0 + tt >= 0) S -= (tt >= 0 || blk != 0) ? ld_bf4(abuf + (size_t)(row0 + tt) * PW + c0) : ld_bf4(halo + (size_t)(15 + tt) * PW + c0);
            }
        } else {
            const int srow0 = row0 - MP;
#pragma unroll 1
            for (int s = 0; s < 4; ++s) {
                const int b = (srow0 >> 3) + s;
                const float* st = P.in[I_STATE] + ((size_t)(l * DBATCH + b) * 15) * PW + c0;
                const bf16* ar = abuf + (size_t)(row0 + 8 * s) * PW + c0;
                f32x4 S = (f32x4){0.f, 0.f, 0.f, 0.f};
                for (int k = 1; k < w; ++k) S += *(const f32x4*)(st + (size_t)(15 - k) * PW);
#pragma unroll
                for (int t = 0; t < 8; ++t) {
                    const f32x4 x = ld_bf4(ar + (size_t)t * PW);
                    S += x;
                    const f32x4 o = S * rw - x;
                    u32x2 pk; pk.x = cvt_pk_bf16(o[0], o[1]); pk.y = cvt_pk_bf16(o[2], o[3]);
                    *(u32x2*)(pooled + (size_t)(row0 + 8 * s + t) * PW + c0) = pk;
                    const int i = 15 + t - w + 1;
                    S -= (i < 15) ? *(const f32x4*)(st + (size_t)i * PW) : ld_bf4(ar + (size_t)(i - 15) * PW);
                }
            }
        }
    }
    LAS float* rstd_s = (LAS float*)C.lds;
    const bf16* vbuf = (const bf16*)(ws + WS_V);
    const float* gv = P.in[I_SGUG] + (size_t)l * PW;
#pragma unroll 1
    for (int rr = 0; rr < 4; ++rr) {
        const int r = row0 + 4 * wid + rr;
        u32x4 wv[4]; float ss = 0.f;
#pragma unroll
        for (int k = 0; k < 4; ++k) { wv[k] = *(const u32x4*)(vbuf + (size_t)r * PW + 8 * lane + 512 * k);
            f32x4 a, b; unpack8(wv[k], a, b); ss += (a[0] * a[0] + a[1] * a[1]) + (a[2] * a[2] + a[3] * a[3]) + (b[0] * b[0] + b[1] * b[1]) + (b[2] * b[2] + b[3] * b[3]); }
        const float rstd = 1.0f / sqrtf(wave_sum(ss) * (1.0f / PW) + EPS);
        if (lane == 0) rstd_s[4 * wid + rr] = rstd;
        if (p >= NPP) {
            float* o = P.out + O_SGV + ((size_t)l * MS + (size_t)(r - MP)) * PW;
#pragma unroll
            for (int k = 0; k < 4; ++k) { f32x4 a, b; unpack8(wv[k], a, b); const int c = 8 * lane + 512 * k;
                *(f32x4*)(o + c) = a * rstd * *(const f32x4*)(gv + c); *(f32x4*)(o + c + 4) = b * rstd * *(const f32x4*)(gv + c + 4); }
        }
    }
    LDS_WAIT(); __syncthreads();
    bf16* vnt = (bf16*)(ws + WS_VNT);
#pragma unroll 1
    for (int k = 0; k < 2; ++k) {
        const int c = 2 * (tid + 512 * k);
        const float g0 = gv[c], g1 = gv[c + 1];
        unsigned o0[16], o1[16];
#pragma unroll
        for (int r2 = 0; r2 < 16; ++r2) {
            const unsigned wa = *(const unsigned*)(vbuf + (size_t)(row0 + 2 * r2) * PW + c), wb = *(const unsigned*)(vbuf + (size_t)(row0 + 2 * r2 + 1) * PW + c);
            const float ra = rstd_s[2 * r2], rb = rstd_s[2 * r2 + 1];
            o0[r2] = cvt_pk_bf16(bf_lo(wa) * ra * g0, bf_lo(wb) * rb * g0); o1[r2] = cvt_pk_bf16(bf_hi(wa) * ra * g1, bf_hi(wb) * rb * g1);
        }
        const int slot = (c & ~31) + invperm32(c & 31);
        u32x4* d0 = (u32x4*)(vnt + (size_t)slot * MR + row0); u32x4* d1 = (u32x4*)(vnt + (size_t)(slot + 1) * MR + row0);
#pragma unroll
        for (int i = 0; i < 4; ++i) { d0[i] = (u32x4){o0[4 * i], o0[4 * i + 1], o0[4 * i + 2], o0[4 * i + 3]}; d1[i] = (u32x4){o1[4 * i], o1[4 * i + 1], o1[4 * i + 2], o1[4 * i + 3]}; }
    }
    __syncthreads();
}

__device__ __forceinline__ void fin_unit(const Params& P, const Ctx& C, int p, int blk) {
    unsigned char* ws = P.ws;
    const float* gf = P.in[I_FING];
    const float* ssq = (const float*)(ws + WS_CTL) + CW_SUMSQ + (size_t)DEPTH * MR;
    int lane = C.lane; asm volatile("" : "+v"(lane));
#pragma unroll 1
    for (int rr = 0; rr < 4; ++rr) {
        const int r = 256 * p + 32 * blk + 4 * C.wid + rr;
        const float rstd = 1.0f / sqrtf(ssq[r] * (1.0f / DM) + EPS);
        const f32x4* x = (const f32x4*)((const float*)(ws + WS_XF) + (size_t)r * DM) + lane;
        f32x4* o = (f32x4*)(P.out + O_Y + (size_t)r * DM) + lane;
#pragma unroll 4
        for (int k = 0; k < 16; ++k) o[64 * k] = x[64 * k] * rstd * ((const f32x4*)gf)[lane + 64 * k];
    }
}

__device__ __forceinline__ void tr_item(const float* W, size_t ldn, int k0, int n0s, bf16* WT, size_t ldk, size_t drow0, int kd0, const float* gk, LAS float* scr, int lane) {
    float v[32];
    const float* src = W + (size_t)(k0 + (lane >> 5)) * ldn + n0s + (lane & 31);
#pragma unroll
    for (int i = 0; i < 32; ++i) v[i] = src[(size_t)(2 * i) * ldn];
    const int c = lane & 7;
    f32x4 g0 = (f32x4){1.f, 1.f, 1.f, 1.f}, g1 = g0;
    if (gk) { g0 = *(const f32x4*)(gk + k0 + 8 * c); g1 = *(const f32x4*)(gk + k0 + 8 * c + 4); }
#pragma unroll
    for (int i = 0; i < 32; ++i) scr[(2 * i + (lane >> 5)) * 33 + (lane & 31)] = v[i];
    LDS_WAIT(); asm volatile("" ::: "memory");
#pragma unroll
    for (int j = 0; j < 4; ++j) { const int n = (lane >> 3) + 8 * j; const LAS float* s = scr + (8 * c) * 33 + n;
        u32x4 o; o.x = cvt_pk_bf16(s[0 * 33] * g0[0], s[1 * 33] * g0[1]); o.y = cvt_pk_bf16(s[2 * 33] * g0[2], s[3 * 33] * g0[3]); o.z = cvt_pk_bf16(s[4 * 33] * g1[0], s[5 * 33] * g1[1]); o.w = cvt_pk_bf16(s[6 * 33] * g1[2], s[7 * 33] * g1[3]);
        *(u32x4*)(WT + (drow0 + invperm32(n)) * ldk + kd0 + 8 * c) = o; }
    LDS_WAIT(); asm volatile("" ::: "memory");
}
__device__ __forceinline__ int win_src_col(int v) {
    const int j = v >> 8, c = v & 255;
    if (j < 8) return v;
    if (j < 16) return 6144 + (v - 2048);
    if (j < 24) return 2048 + (v - 4096);
    if (j < 40) { const int t = j - 24; return c < 128 ? 4096 + 128 * t + c : 8192 + 128 * t + (c - 128); }
    { const int t = j - 40; return c < 128 ? 10240 + 128 * t + c : 14336 + 128 * t + (c - 128); }
}
__device__ __forceinline__ void prologue(const Params& P, const Ctx& C) {
    unsigned char* ws = P.ws;
    LAS float* scr = (LAS float*)(C.lds + C.wid * 16384);
    const int vcu = C.xcd * C.W + C.rank;
    const long gw = (long)vcu * 8 + C.wid, NGW = (long)C.G * 8;
    int lane = C.lane; asm volatile("" : "+v"(lane));
    constexpr long N_WIN = (long)DEPTH * 64 * 576, N_WBR = (long)DEPTH * 2 * 32 * 128, N_WO = (long)DEPTH * 64 * 128, N_PW = (long)DEPTH * 4 * 8 * 16;
    constexpr long N_TR = N_WIN + N_WBR + N_WO + N_PW;
    for (long it = gw; it < N_TR; it += NGW) {
        long r = it;
        if (r < N_WIN) { const int l = (int)(r / 36864), r2 = (int)(r % 36864), kb = r2 / 576, vg = r2 % 576;
            tr_item(P.in[I_WIN] + (size_t)l * DM * INC, INC, 64 * kb, win_src_col(32 * vg), (bf16*)(ws + WS_WIN), DM, (size_t)l * INC + 32 * vg, 64 * kb, P.in[I_NORMG] + (size_t)l * DM, scr, lane); continue; }
        r -= N_WIN;
        if (r < N_WBR) { const int l = (int)(r / 8192), r2 = (int)(r % 8192), ab = r2 / 4096, r3 = r2 % 4096, kb = r3 / 128, vg = r3 % 128;
            tr_item(P.in[ab ? I_WBB : I_WBA] + (size_t)l * PW * DM, DM, 64 * kb, 32 * vg, (bf16*)(ws + WS_WBR), DM, (size_t)l * DM + 32 * vg, 64 * kb + ab * 2048, nullptr, scr, lane); continue; }
        r -= N_WBR;
        if (r < N_WO) { const int l = (int)(r / 8192), r2 = (int)(r % 8192), kb = r2 / 128, vg = r2 % 128;
            tr_item(P.in[I_WOUT] + (size_t)l * DM * DM, DM, 64 * kb, 32 * vg, (bf16*)(ws + WS_WO), DM, (size_t)l * DM + 32 * vg, 64 * kb, nullptr, scr, lane); continue; }
        r -= N_WO;
        { const int lg = (int)(r / 128), r2 = (int)(r % 128), kb = r2 / 16, vg = r2 % 16;
            tr_item(P.in[I_POOLW] + (size_t)lg * 512 * 512, 512, 64 * kb, 32 * vg, (bf16*)(ws + WS_PWT), 512, (size_t)lg * 512 + 32 * vg, 64 * kb, nullptr, scr, lane); }
    }
    for (long m = gw; m < MR; m += NGW) {
        const float* x = (m < MP) ? P.in[I_XP] + (size_t)m * DM : P.in[I_XS] + (size_t)(m - MP) * DM;
        bf16* xb = (bf16*)(ws + WS_XB) + (size_t)m * DM; float ss = 0.f;
#pragma unroll 4
        for (int k = 0; k < 8; ++k) { const f32x4 a = *(const f32x4*)(x + 8 * lane + 512 * k), b = *(const f32x4*)(x + 8 * lane + 512 * k + 4);
            ss += (a[0] * a[0] + a[1] * a[1]) + (a[2] * a[2] + a[3] * a[3]) + (b[0] * b[0] + b[1] * b[1]) + (b[2] * b[2] + b[3] * b[3]);
            *(u32x4*)(xb + 8 * lane + 512 * k) = pack8(a, b); }
        ss = wave_sum(ss);
        if (lane == 0) ((float*)(ws + WS_CTL))[CW_SUMSQ + m] = ss;
    }
    for (long m = gw; m < (long)DEPTH * DBATCH * 7; m += NGW) {
        const long lb = m / 7; const int i = (int)(m % 7);
        const f32x4* s = (const f32x4*)(P.in[I_STATE] + ((size_t)lb * 15 + 8 + i) * PW) + lane; f32x4* o = (f32x4*)(P.out + O_SPS + ((size_t)lb * 15 + i) * PW) + lane;
#pragma unroll
        for (int k = 0; k < 8; ++k) o[64 * k] = s[64 * k];
    }
    for (long m = gw; m < (long)DEPTH * 8 * 2 * 256; m += NGW) {
        const int t = (int)(m & 255), ps = (int)((m >> 8) & 1); const long lh = m >> 9;
        const float* w = P.in[I_SGUW] + (size_t)lh * 128 * 128;
        bf16* o = (bf16*)(ws + WS_WBLK) + (size_t)m * 256;
        u32x2 pk; float v[4];
#pragma unroll
        for (int k = 0; k < 4; ++k) { const int s = 4 * lane + k; float x = 0.f;
            if (ps == 0) { if ((s >> 7) == (t >> 7) && (s & 127) <= (t & 127)) x = w[(t & 127) * 128 + (s & 127)]; }
            else { if ((s >> 3) == (t >> 3) && (s & 7) <= (t & 7)) x = w[(t & 7) * 128 + (s & 7)]; }
            v[k] = x; }
        pk.x = cvt_pk_bf16(v[0], v[1]); pk.y = cvt_pk_bf16(v[2], v[3]);
        *(u32x2*)(o + 4 * lane) = pk;
    }
}

__global__ void __launch_bounds__(512, 2) fwd_kernel(Params P) {
    extern __shared__ __attribute__((aligned(16))) unsigned char lds_raw[];
    Ctx C;
    C.lds = (LAS unsigned char*)lds_raw;
    C.tid = threadIdx.x; C.lane = C.tid & 63; C.wid = __builtin_amdgcn_readfirstlane(C.tid >> 6);
    C.G = gridDim.x; C.W = C.G >> 3; C.xcd = blockIdx.x & 7; C.rank = blockIdx.x >> 3;
    volatile LAS unsigned* MISC = (volatile LAS unsigned*)(C.lds + MISC_OFF);
    if (C.tid < 16) MISC[C.tid] = 0u;
    __syncthreads();
    unsigned* ctl = (unsigned*)(P.ws + WS_CTL);
    const int plo = P.ph_lo, phi = P.ph_hi;
    XcdBarrier bar; bar.bar = ctl + CW_BAR; bar.x = 0; bar.st = MISC + 8;
    if (phi - plo > 1) bar = xcd_barrier_post(ctl + CW_BAR, MISC + 8);
#define IN_PH(k) (plo <= (k) && (k) < phi)
#define SEAM(k) do { if (IN_PH(k) && IN_PH((k) + 1)) xcd_barrier(bar); } while (0)

    if (IN_PH(0)) prologue(P, C);
    SEAM(0);
#pragma unroll 1
    for (int l = 0; l < DEPTH; ++l) {
        const int q0 = (C.rank - 8 * l) & (C.W - 1);
#pragma unroll 1
        for (int ph = 0; ph < 5; ++ph) {
            const int k = 1 + 5 * l + ph;
            if (IN_PH(k)) {
                const int qs = ph == 0 ? Q_P1 : ph == 1 ? Q_PV : ph == 2 ? Q_SM : ph == 3 ? Q_BR : Q_OUT, qe = ph == 0 ? Q_PV : ph == 1 ? Q_SM : ph == 2 ? Q_BR : ph == 3 ? Q_OUT : Q_FIN;
                int q = q0 + ((qs - q0 + C.W - 1) / C.W) * C.W;
                if (ph == 1) { for (; q < qe; q += C.W) { const Ent e = decode_ent(q, C.xcd); pv_unit(P, C, l, e.p, e.j); } }
                else if (q < qe) gemm_stream(P, C, l, q, qe);
            }
            SEAM(k);
        }
    }
    if (IN_PH(21)) { const int q0 = (C.rank - 8 * (DEPTH - 1)) & (C.W - 1);
      int q = q0 + ((Q_FIN - q0 + C.W - 1) / C.W) * C.W; for (; q < Q_END; q += C.W) { const Ent e = decode_ent(q, C.xcd); fin_unit(P, C, e.p, e.j); } }
}

#ifdef DBG_LAST_PHASE
__global__ void dbg_dump(const unsigned short* src, float* dst, size_t n) {
    for (size_t i = (size_t)blockIdx.x * blockDim.x + threadIdx.x; i < n; i += (size_t)gridDim.x * blockDim.x) dst[i] = __uint_as_float(((unsigned)src[i]) << 16);
}
#endif
extern "C" void kernel_launch(void* const* d_in, const int* in_sizes, int n_in, void* d_out, int out_size, void* d_ws, size_t ws_size, hipStream_t stream) {
    static int grid = 0;
    if (grid == 0) {
        if (n_in != 14 || (size_t)out_size != O_END || ws_size < WS_END) { fprintf(stderr, "kernel_launch: unexpected sizes (n_in %d out %d ws %zu need %zu)\n", n_in, out_size, ws_size, (size_t)WS_END); grid = -1; return; }
        int dev = 0, cus = 0, per_cu = 0;
        if (hipGetDevice(&dev) != hipSuccess || hipDeviceGetAttribute(&cus, hipDeviceAttributeMultiprocessorCount, dev) != hipSuccess) { grid = -1; return; }
        if (hipFuncSetAttribute((const void*)fwd_kernel, hipFuncAttributeMaxDynamicSharedMemorySize, LDS_BYTES) != hipSuccess) { fprintf(stderr, "kernel_launch: hipFuncSetAttribute failed\n"); grid = -1; return; }
        if (hipOccupancyMaxActiveBlocksPerMultiprocessor(&per_cu, (const void*)fwd_kernel, 512, LDS_BYTES) != hipSuccess || per_cu < 1) fprintf(stderr, "kernel_launch: occupancy query says %d\n", per_cu);
        (void)hipGetLastError();
        grid = cus;
        if (grid != 256) fprintf(stderr, "kernel_launch: %d CUs (built for 256)\n", grid);
        grid = 256;
    }
    if (grid < 0) return;
    (void)in_sizes;
    if (hipMemsetAsync((char*)d_ws + WS_CTL, 0, CTL_ZERO_BYTES, stream) != hipSuccess) return;
    Params p{};
    for (int i = 0; i < 14; ++i) p.in[i] = (const float*)d_in[i];
    p.out = (float*)d_out; p.ws = (unsigned char*)d_ws;
#if N_LAUNCHES == 1
    p.ph_lo = 0; p.ph_hi = 22;
    hipLaunchKernelGGL(fwd_kernel, dim3(grid), dim3(512), LDS_BYTES, stream, p);
#else
#ifdef DBG_LAST_PHASE
    for (int k = 0; k <= DBG_LAST_PHASE; ++k) { p.ph_lo = k; p.ph_hi = k + 1; hipLaunchKernelGGL(fwd_kernel, dim3(grid), dim3(512), LDS_BYTES, stream, p); }
    hipLaunchKernelGGL(dbg_dump, dim3(2048), dim3(256), 0, stream, (const unsigned short*)((const char*)d_ws + DBG_DUMP_OFF), (float*)d_out, (size_t)DBG_DUMP_N);
#else
    for (int k = 0; k < 22; ++k) { p.ph_lo = k; p.ph_hi = k + 1; hipLaunchKernelGGL(fwd_kernel, dim3(grid), dim3(512), LDS_BYTES, stream, p); }
#endif
#endif
}
```
